# Optimizing an MI355X kernel written in HIP

```python
import jax, jax.numpy as jnp
from jax import lax
import numpy as np

D_MODEL = 1024
BATCH = 8
SEQ = 4096
DEPTH = 2

POOL_GROUPS = 4
POOL_WINDOWS = (2, 4, 8, 16)
POOL_WIDTH = 3 * D_MODEL // 8
POOL_GROUP_DIM = POOL_WIDTH // POOL_GROUPS
CONV_WIDTH = 3 * D_MODEL // 8
HEAD_DIM = 64
DIL_CONFIGS = ((128, 1), (512, 4), (2048, 16))
HEADS_PER_GROUP = 4
ATTN_HEADS = HEADS_PER_GROUP * len(DIL_CONFIGS)
ATTN_WIDTH = ATTN_HEADS * HEAD_DIM
ATTN_OUT_WIDTH = HEADS_PER_GROUP * HEAD_DIM
ROT_DIM = HEAD_DIM // 4
ROPE_THETA = 500000.0
QUERY_BLOCK = 128
N_BRANCHES = 3
IN_SPLITS = (POOL_WIDTH, CONV_WIDTH, CONV_WIDTH, CONV_WIDTH, ATTN_WIDTH, ATTN_WIDTH, ATTN_WIDTH, N_BRANCHES * D_MODEL)
IN_WIDTH = POOL_WIDTH + 3 * CONV_WIDTH + 3 * ATTN_WIDTH + N_BRANCHES * D_MODEL
MEM_LEN = 256
MEM_HEADS = 4
MEM_HEAD_DIM = D_MODEL // 8
MEM_WIDTH = MEM_HEADS * MEM_HEAD_DIM
D_FF = ((8 * D_MODEL // 3 + 127) // 128) * 128
CONV_K = 3
RMS_EPS = 1e-6

kernel_name = "hybrid_gated_pool_conv_dilattn_block"


def rmsnorm(x, g):
    xf = x.astype(jnp.float32)
    y = xf * lax.rsqrt(jnp.mean(xf * xf, axis=-1, keepdims=True) + RMS_EPS)
    return (y * g.astype(jnp.float32)).astype(x.dtype)


def split_cols(u, sizes):
    outs, start = [], 0
    for s in sizes:
        outs.append(u[..., start:start + s])
        start += s
    return outs


def causal_dwconv(u, w):
    k, c = w.shape
    return lax.conv_general_dilated(
        u, w[:, None, :].astype(u.dtype), window_strides=(1,), padding=((k - 1, 0),),
        dimension_numbers=("NWC", "WIO", "NWC"), feature_group_count=c)


def rope_tables(positions):
    inv = ROPE_THETA ** (-jnp.arange(0, ROT_DIM, 2, dtype=jnp.float32) / ROT_DIM)
    ang = positions.astype(jnp.float32)[..., None] * inv
    return jnp.cos(ang)[:, :, None, :], jnp.sin(ang)[:, :, None, :]


def apply_partial_rope(u, cos, sin):
    half = ROT_DIM // 2
    uf = u[..., :ROT_DIM].astype(jnp.float32)
    u1, u2 = uf[..., :half], uf[..., half:]
    rot = jnp.concatenate([u1 * cos - u2 * sin, u2 * cos + u1 * sin], axis=-1).astype(u.dtype)
    return jnp.concatenate([rot, u[..., ROT_DIM:]], axis=-1)


def multiscale_pool(u, pool_w, pool_scale):
    b, s, _ = u.shape
    ug = u.reshape(b, s, POOL_GROUPS, POOL_GROUP_DIM).astype(jnp.float32)
    cs = jnp.cumsum(ug, axis=1)
    t = jnp.arange(s)
    outs = []
    for g, w in enumerate(POOL_WINDOWS):
        c = cs[:, :, g]
        prev = jnp.pad(c, ((0, 0), (w, 0), (0, 0)))[:, :s]
        cnt = jnp.minimum(t + 1, w).astype(jnp.float32)[None, :, None]
        outs.append((c - prev) / cnt - ug[:, :, g])
    pooled = jnp.stack(outs, axis=2)
    mixed = jnp.einsum("bsgc,gcd->bsgd", pooled, pool_w.astype(jnp.float32))
    return (mixed.reshape(b, s, POOL_WIDTH) * pool_scale.astype(jnp.float32)).astype(u.dtype)


def dilated_attention(q, k, v):
    b, s, _, hd = q.shape
    ng = len(DIL_CONFIGS)
    def grp(u):
        return u.reshape(b, s, ng, HEADS_PER_GROUP, hd).transpose(2, 0, 3, 1, 4)
    qg, kg, vg = grp(q), grp(k), grp(v)
    scale = hd ** -0.5

    def block(bi):
        start = bi * QUERY_BLOCK
        t = start + jnp.arange(QUERY_BLOCK)
        qb = lax.dynamic_slice_in_dim(qg, start, QUERY_BLOCK, axis=3)
        outs, lses = [], []
        for g, (window, dil) in enumerate(DIL_CONFIGS):
            offs = jnp.arange(window // dil + 1) * dil
            idx = t[:, None] - offs[None, :]
            valid = idx >= 0
            idx = jnp.maximum(idx, 0)
            kk = jnp.take(kg[g], idx, axis=2)
            vv = jnp.take(vg[g], idx, axis=2)
            sc = jnp.einsum("bhqd,bhqkd->bhqk", qb[g], kk).astype(jnp.float32) * scale
            sc = jnp.where(valid, sc, -jnp.inf)
            m = jnp.max(sc, axis=-1, keepdims=True)
            p = jnp.exp(sc - m)
            den = jnp.sum(p, axis=-1, keepdims=True)
            o = jnp.einsum("bhqk,bhqkd->bhqd", p, vv.astype(jnp.float32)) / den
            outs.append(o)
            lses.append(m + jnp.log(den))
        wts = jax.nn.softmax(jnp.stack(lses, axis=0), axis=0)
        return jnp.sum(wts * jnp.stack(outs, axis=0), axis=0).astype(q.dtype)

    out = lax.map(block, jnp.arange(s // QUERY_BLOCK))
    return out.transpose(1, 0, 3, 2, 4).reshape(b, s, ATTN_OUT_WIDTH)


def memory_cross_attention(h, mem_n, w_q, w_kv, w_o):
    b, s, _ = h.shape
    q = (h @ w_q).reshape(b, s, MEM_HEADS, MEM_HEAD_DIM)
    kv = mem_n @ w_kv
    k = kv[..., :MEM_WIDTH].reshape(b, -1, MEM_HEADS, MEM_HEAD_DIM)
    v = kv[..., MEM_WIDTH:].reshape(b, -1, MEM_HEADS, MEM_HEAD_DIM)
    sc = jnp.einsum("bshd,bmhd->bhsm", q, k).astype(jnp.float32) * (MEM_HEAD_DIM ** -0.5)
    p = jax.nn.softmax(sc, axis=-1)
    o = jnp.einsum("bhsm,bmhd->bshd", p, v.astype(jnp.float32)).astype(h.dtype)
    return o.reshape(b, s, MEM_WIDTH) @ w_o


def setup_inputs(seed: int = 0) -> dict:
    key = jax.random.key(seed)
    ks = jax.random.split(key, 32)
    f32 = jnp.float32

    def nrm(k, shape, fan_in):
        return jax.random.normal(k, shape, f32) * (fan_in ** -0.5)

    def gain(k, n):
        return 1.0 + 0.05 * jax.random.normal(k, (DEPTH, n), f32)

    return {
        "x": jax.random.normal(ks[0], (BATCH, SEQ, D_MODEL), f32),
        "mem": jax.random.normal(ks[1], (BATCH, MEM_LEN, D_MODEL), f32),
        "positions": jnp.broadcast_to(jnp.arange(SEQ, dtype=jnp.int32), (BATCH, SEQ)),
        "norm_mix_pre": gain(ks[2], D_MODEL),
        "norm_mix_post": gain(ks[3], D_MODEL),
        "w_in": nrm(ks[4], (DEPTH, D_MODEL, IN_WIDTH), D_MODEL),
        "pool_w": nrm(ks[5], (DEPTH, POOL_GROUPS, POOL_GROUP_DIM, POOL_GROUP_DIM), POOL_GROUP_DIM),
        "pool_scale": 1.0 + 0.1 * jax.random.normal(ks[6], (DEPTH, POOL_WIDTH), f32),
        "conv_b_w": nrm(ks[7], (DEPTH, CONV_K, CONV_WIDTH), CONV_K),
        "w_branch_a": nrm(ks[8], (DEPTH, POOL_WIDTH, D_MODEL), POOL_WIDTH),
        "w_branch_b": nrm(ks[9], (DEPTH, CONV_WIDTH, D_MODEL), CONV_WIDTH),
        "w_branch_c": nrm(ks[10], (DEPTH, ATTN_OUT_WIDTH, D_MODEL), ATTN_OUT_WIDTH),
        "w_out": nrm(ks[11], (DEPTH, D_MODEL, D_MODEL), D_MODEL),
        "norm_mem_pre": gain(ks[12], D_MODEL),
        "norm_mem_post": gain(ks[13], D_MODEL),
        "norm_memkv": gain(ks[14], D_MODEL),
        "w_mq": nrm(ks[15], (DEPTH, D_MODEL, MEM_WIDTH), D_MODEL),
        "w_mkv": nrm(ks[16], (DEPTH, D_MODEL, 2 * MEM_WIDTH), D_MODEL),
        "w_mo": nrm(ks[17], (DEPTH, MEM_WIDTH, D_MODEL), MEM_WIDTH),
        "norm_ffn_pre": gain(ks[18], D_MODEL),
        "norm_ffn_post": gain(ks[19], D_MODEL),
        "w_up": nrm(ks[20], (DEPTH, D_MODEL, 2 * D_FF), D_MODEL),
        "conv_ffn_w": nrm(ks[21], (DEPTH, CONV_K, D_FF), CONV_K),
        "w_down": nrm(ks[22], (DEPTH, D_FF, D_MODEL), D_FF),
    }


def reference(x, mem, positions, norm_mix_pre, norm_mix_post, w_in, pool_w, pool_scale, conv_b_w,
              w_branch_a, w_branch_b, w_branch_c, w_out, norm_mem_pre, norm_mem_post, norm_memkv,
              w_mq, w_mkv, w_mo, norm_ffn_pre, norm_ffn_post, w_up, conv_ffn_w, w_down):
    b, s, d = x.shape
    cos, sin = rope_tables(positions)
    cos, sin = cos.astype(x.dtype), sin.astype(x.dtype)
    for l in range(DEPTH):
        h = rmsnorm(x, norm_mix_pre[l])
        a_in, b_x, b_b, b_c, q, k, v, gate_in = split_cols(h @ w_in[l], IN_SPLITS)
        br_a = multiscale_pool(a_in, pool_w[l], pool_scale[l]) @ w_branch_a[l]
        br_b = (b_b * causal_dwconv(b_c * b_x, conv_b_w[l])) @ w_branch_b[l]
        q = apply_partial_rope(q.reshape(b, s, ATTN_HEADS, HEAD_DIM), cos, sin)
        k = apply_partial_rope(k.reshape(b, s, ATTN_HEADS, HEAD_DIM), cos, sin)
        v = v.reshape(b, s, ATTN_HEADS, HEAD_DIM)
        br_c = dilated_attention(q, k, v) @ w_branch_c[l]
        gates = jax.nn.sigmoid(gate_in.astype(jnp.float32)).astype(x.dtype).reshape(b, s, N_BRANCHES, d)
        merged = gates[:, :, 0] * br_a + gates[:, :, 1] * br_b + gates[:, :, 2] * br_c
        x = x + rmsnorm(merged @ w_out[l], norm_mix_post[l])
        h = rmsnorm(x, norm_mem_pre[l])
        mem_n = rmsnorm(mem, norm_memkv[l])
        x = x + rmsnorm(memory_cross_attention(h, mem_n, w_mq[l], w_mkv[l], w_mo[l]), norm_mem_post[l])
        h = rmsnorm(x, norm_ffn_pre[l])
        u = h @ w_up[l]
        ua, ub = u[..., :D_FF], u[..., D_FF:]
        y = (jax.nn.silu(causal_dwconv(ua, conv_ffn_w[l])) * ub) @ w_down[l]
        x = x + rmsnorm(y, norm_ffn_post[l])
    return x
```

```cpp
#include <hip/hip_runtime.h>
#include <hip/hip_cooperative_groups.h>
#include <cstdio>
#include <cstdint>
namespace cg = cooperative_groups;

#ifndef MK_ONE_LAUNCH
#define MK_ONE_LAUNCH 1
#endif

#ifndef PM
#define PM 63
#endif
#ifndef REP
#define REP 0
#endif
#define NREP(bit) ((REP & (bit)) ? 2 : 1)
#define LAS __attribute__((address_space(3)))
#define GAS
typedef unsigned short bf16;
typedef short bf16x8 __attribute__((ext_vector_type(8)));
typedef float f32x4 __attribute__((ext_vector_type(4)));
typedef unsigned u32x4 __attribute__((ext_vector_type(4)));
typedef unsigned u32x2 __attribute__((ext_vector_type(2)));

constexpr int NB = 8, S = 4096, D = 1024, TC = 16384, NCH = 2, BC = 4;
constexpr int INW = 6912, DFF = 2816;
constexpr float EPS = 1e-6f;
constexpr float LOG2E = 1.4426950408889634f;

constexpr size_t MiB = 1u << 20;
constexpr size_t LW = 19922944;
constexpr size_t OW_IN = 0, OW_CAT = 7077888, OW_OUT = OW_CAT + 1048576, OW_MQ = OW_OUT + 1048576, OW_MKV = OW_MQ + 524288,
                 OW_MO = OW_MKV + 1048576, OW_UP = OW_MO + 524288, OW_DOWN = OW_UP + 5767168;
static_assert(OW_DOWN + 2883584 == LW, "weights");
constexpr size_t WS_W = 1 * MiB, WS_CS = 78 * MiB, WS_MEMK = 80 * MiB, WS_MEMVT = 84 * MiB, WS_H = 88 * MiB;
constexpr size_t WS_R1 = 120 * MiB, WS_R2 = 336 * MiB, WS_Y = 432 * MiB, WS_END = 508 * MiB;
constexpr size_t WS_X16 = WS_Y;
constexpr size_t WS_UABC = WS_R1, WS_QP = WS_R1 + 48 * MiB, WS_KP = WS_R1 + 72 * MiB, WS_VT = WS_R1 + 96 * MiB, WS_G = WS_R1 + 120 * MiB;
constexpr size_t WS_HM = WS_R1;
constexpr size_t PSTRIDE = 1572864, PO_XCAT = 0, PO_MERGED = 524288, PO_QM = 1048576, PO_OM = 1310720, PO_Z = 0;
constexpr size_t WS_RAW = 496 * MiB, WS_SSQ = 501 * MiB, WS_PCNT = 32768;
constexpr size_t SSQ_INST = 2 * 16384 * 4 * 4;
static_assert(WS_W + 2 * LW * 2 <= WS_CS, "ws map");

constexpr int LDS_BYTES = 147456, LDS_CTL = 137216;
constexpr int NTHREADS = 512, NWAVES = 8;

struct Params {
    const float* x; const float* mem; const int* positions;
    const float* norm_mix_pre; const float* norm_mix_post; const float* w_in; const float* pool_w; const float* pool_scale;
    const float* conv_b_w; const float* w_branch_a; const float* w_branch_b; const float* w_branch_c; const float* w_out;
    const float* norm_mem_pre; const float* norm_mem_post; const float* norm_memkv; const float* w_mq; const float* w_mkv; const float* w_mo;
    const float* norm_ffn_pre; const float* norm_ffn_post; const float* w_up; const float* conv_ffn_w; const float* w_down;
    float* out; unsigned char* ws; int ph_lo, ph_hi;
};

__device__ __forceinline__ unsigned f2bf(float f) { unsigned u = __builtin_bit_cast(unsigned, f); return (u + 0x7fffu + ((u >> 16) & 1u)) >> 16; }
__device__ __forceinline__ unsigned pk2(float lo, float hi) { unsigned r; asm("v_cvt_pk_bf16_f32 %0, %1, %2" : "=v"(r) : "v"(lo), "v"(hi)); return r; }
__device__ __forceinline__ float bflo(unsigned u) { return __builtin_bit_cast(float, u << 16); }
__device__ __forceinline__ float bfhi(unsigned u) { return __builtin_bit_cast(float, u & 0xffff0000u); }
__device__ __forceinline__ int otid() { int t = threadIdx.x; asm volatile("" : "+v"(t)); return t; }
__device__ __forceinline__ float wave_sum(float v) {
#pragma unroll
    for (int o = 1; o < 64; o <<= 1) v += __shfl_xor(v, o);
    return v;
}
__device__ __forceinline__ void unpack8(const u32x4 w, float* f) {
    f[0] = bflo(w.x); f[1] = bfhi(w.x); f[2] = bflo(w.y); f[3] = bfhi(w.y); f[4] = bflo(w.z); f[5] = bfhi(w.z); f[6] = bflo(w.w); f[7] = bfhi(w.w);
}
__device__ __forceinline__ u32x4 pack8(const float* f) {
    u32x4 w; w.x = pk2(f[0], f[1]); w.y = pk2(f[2], f[3]); w.z = pk2(f[4], f[5]); w.w = pk2(f[6], f[7]); return w;
}

namespace pg8 {
constexpr int BM = 256, BK = 64, HALF = 128, HTB = HALF * BK * 2, NXCD = 8, WGM = 8;
__device__ __forceinline__ int lds_byte(int r, int c) { const int st = (r >> 4) * 2 + (c >> 5), rr = r & 15, cc = c & 31, ob = rr * 64 + cc * 2; return st * 1024 + (ob ^ (((ob >> 9) & 1) << 5)); }
__device__ __forceinline__ void stage_rc(int b, int& R, int& C) { const int st = b / 1024, sb = b % 1024, swz = sb ^ (((sb >> 9) & 1) << 5); R = (st >> 1) * 16 + swz / 64; C = (st & 1) * 32 + (swz % 64) / 2; }
__device__ __forceinline__ int perm32(int rho) { const int n = rho >> 4, i = rho & 15; return 8 * (i >> 2) + 4 * n + (i & 3); }

enum { K_BF16 = 0, K_F32, K_GATE, K_Q, K_K, K_VT, K_CH0, K_CH1, K_CH2 };
struct Unit {
    const char* A; const char* B;
    unsigned pa, pb;
    int nt, kind, pm, pn, aux;
    void* dst; int ldc; float scale;
};
__device__ __forceinline__ int xcd_remap(int L, int nwg) { const int q = nwg / NXCD, r = nwg % NXCD, xcd = L % NXCD, off = L / NXCD; return (xcd < r ? xcd * (q + 1) : r * (q + 1) + (xcd - r) * q) + off; }
__device__ __forceinline__ void pmpn(int w, int nM, int nN, int& pm, int& pn) { const int nig = WGM * nN, gid = w / nig, fm = gid * WGM, gsz = (nM - fm) < WGM ? (nM - fm) : WGM; pm = fm + ((w % nig) % gsz); pn = (w % nig) / gsz; }

template <class Gen, class Epi>
__device__ __forceinline__ void gemm_phase(LAS unsigned char* lds, const Gen& S, const Epi& E) {
    const int tid = otid(), wid = __builtin_amdgcn_readfirstlane(tid >> 6), lane = tid & 63, wr = wid >> 2, wc = wid & 3, fr = lane & 15, fq = lane >> 4;
    int R0, C0; stage_rc(tid * 16, R0, C0);
    const unsigned Rb0 = (unsigned)((R0 & ~31) + perm32(R0 & 31)), Ra0 = (unsigned)R0, c2 = (unsigned)C0 * 2u;
    const size_t kstep = (size_t)(BK * 2);
    const unsigned ldsw = (unsigned)wid * 1024u;
    const int aoff = lds_byte(wr * 64 + fr, fq * 8), boff = lds_byte(wc * 32 + fr, fq * 8);
#define PG8_SA(b, h) (((b) * 2 + (h)) * HTB)
#define PG8_SB(b, h) ((4 + (b) * 2 + (h)) * HTB)
#define PG8_STAGE(bufoff, gbase, R, pitch) do { const unsigned _v = (R) * (pitch) + c2; \
        __builtin_amdgcn_global_load_lds((const unsigned*)((const char*)(gbase) + _v), (LAS unsigned*)(lds + (bufoff) + ldsw), 16, 0, 0); \
        __builtin_amdgcn_global_load_lds((const unsigned*)((const char*)(gbase) + (_v + ((pitch) << 6))), (LAS unsigned*)(lds + (bufoff) + ldsw + 8192), 16, 0, 0); } while (0)
#define PG8_LDA(dst, b, h) do { _Pragma("unroll") for (int m = 0; m < 4; ++m) _Pragma("unroll") for (int k = 0; k < 2; ++k) dst[m][k] = *(const LAS bf16x8*)(lds + PG8_SA(b, h) + aoff + m * 2048 + k * 1024); } while (0)
#define PG8_LDB(dst, b, h) do { _Pragma("unroll") for (int n = 0; n < 2; ++n) _Pragma("unroll") for (int k = 0; k < 2; ++k) dst[n][k] = *(const LAS bf16x8*)(lds + PG8_SB(b, h) + boff + n * 2048 + k * 1024); } while (0)
#define PG8_MMA(ai, bj, At, Bt) do { __builtin_amdgcn_s_setprio(1); _Pragma("unroll") for (int m = 0; m < 4; ++m) _Pragma("unroll") for (int n = 0; n < 2; ++n) _Pragma("unroll") for (int k = 0; k < 2; ++k) \
        acc[ai][bj][m][n] = __builtin_amdgcn_mfma_f32_16x16x32_bf16(Bt[n][k], At[m][k], acc[ai][bj][m][n], 0, 0, 0); __builtin_amdgcn_s_setprio(0); } while (0)
#define PG8_WAIT_V(n) asm volatile("s_waitcnt vmcnt(" #n ")" ::: "memory")
#define PG8_WAIT_L(n) asm volatile("s_waitcnt lgkmcnt(" #n ")" ::: "memory")
#define PG8_BAR __builtin_amdgcn_s_barrier()
#define PG8_SCHED __builtin_amdgcn_sched_barrier(0)
    int ui = 0;
    const char* cA; const char* cB; unsigned pac, pbc; int nt;
    { Unit u0; if (!S.next(0, u0)) return; cA = u0.A; cB = u0.B; pac = u0.pa; pbc = u0.pb; nt = u0.nt; }
    f32x4 acc[2][2][4][2];
#pragma unroll
    for (int a = 0; a < 2; ++a)
#pragma unroll
        for (int b = 0; b < 2; ++b)
#pragma unroll
            for (int m = 0; m < 4; ++m)
#pragma unroll
                for (int n = 0; n < 2; ++n) acc[a][b][m][n] = (f32x4){0.f, 0.f, 0.f, 0.f};
    bf16x8 At[4][2], B0[2][2], B1[2][2];
    PG8_STAGE(PG8_SB(0, 0), cB, Rb0, pbc); PG8_STAGE(PG8_SB(0, 1), cB + (pbc << 7), Rb0, pbc); PG8_STAGE(PG8_SA(0, 0), cA, Ra0, pac); PG8_STAGE(PG8_SA(0, 1), cA + (pac << 7), Ra0, pac);
    if (wr == 1) PG8_BAR;
    PG8_WAIT_V(2); PG8_BAR;
    PG8_STAGE(PG8_SB(1, 0), cB + kstep, Rb0, pbc); PG8_STAGE(PG8_SA(1, 0), cA + kstep, Ra0, pac); PG8_STAGE(PG8_SB(1, 1), cB + (pbc << 7) + kstep, Rb0, pbc);
    PG8_WAIT_V(6); PG8_BAR;
    for (;;) {
        const char* nA = cA; const char* nB = cB; unsigned pan = pac, pbn = pbc; int ntn = nt; bool has_next;
        { Unit un; has_next = S.next(ui + 1, un); if (has_next) { nA = un.A; nB = un.B; pan = un.pa; pbn = un.pb; ntn = un.nt; } }
        for (int t = 0; t < nt; t += 2) {
            const bool last = (t == nt - 2);
            const char* a1 = cA + (size_t)(t + 1) * kstep;
            const char* a2 = last ? nA : cA + (size_t)(t + 2) * kstep; const char* b2 = last ? nB : cB + (size_t)(t + 2) * kstep;
            const char* a3 = a2 + kstep; const char* b3 = b2 + kstep;
            const unsigned pa2 = last ? pan : pac, pb2 = last ? pbn : pbc;
            PG8_LDB(B0, 0, 0); PG8_LDB(B1, 0, 1); PG8_SCHED; PG8_LDA(At, 0, 0); PG8_STAGE(PG8_SA(1, 1), a1 + (pac << 7), Ra0, pac);
            PG8_WAIT_V(8); PG8_WAIT_L(0); PG8_BAR; PG8_MMA(0, 0, At, B0); PG8_MMA(0, 1, At, B1); PG8_BAR; PG8_SCHED;
            PG8_LDA(At, 0, 1); PG8_STAGE(PG8_SB(0, 0), b2, Rb0, pb2); PG8_STAGE(PG8_SB(0, 1), b2 + (pb2 << 7), Rb0, pb2); PG8_STAGE(PG8_SA(0, 0), a2, Ra0, pa2);
            PG8_WAIT_V(8); PG8_WAIT_L(0); PG8_BAR; PG8_MMA(1, 0, At, B0); PG8_MMA(1, 1, At, B1); PG8_BAR; PG8_SCHED;
            PG8_LDB(B0, 1, 0); PG8_LDB(B1, 1, 1); PG8_SCHED; PG8_LDA(At, 1, 0); PG8_STAGE(PG8_SA(0, 1), a2 + (pa2 << 7), Ra0, pa2);
            PG8_WAIT_V(8); PG8_WAIT_L(0); PG8_BAR; PG8_MMA(0, 0, At, B0); PG8_MMA(0, 1, At, B1); PG8_BAR; PG8_SCHED;
            PG8_LDA(At, 1, 1); PG8_STAGE(PG8_SB(1, 0), b3, Rb0, pb2); PG8_STAGE(PG8_SB(1, 1), b3 + (pb2 << 7), Rb0, pb2); PG8_STAGE(PG8_SA(1, 0), a3, Ra0, pa2);
            PG8_WAIT_V(8); PG8_WAIT_L(0); PG8_BAR; PG8_MMA(1, 0, At, B0); PG8_MMA(1, 1, At, B1); PG8_BAR; PG8_SCHED;
        }
        if (wr == 0) PG8_BAR;
        bool reset;
        { Unit uc; S.next(ui, uc); int fre = fr, fqe = fq; asm volatile("" : "+v"(fre), "+v"(fqe));
          reset = E(acc, uc, wr, wc, fre, fqe); }
        if (!has_next) break;
        if (reset) {
#pragma unroll
            for (int a = 0; a < 2; ++a)
#pragma unroll
                for (int b = 0; b < 2; ++b)
#pragma unroll
                    for (int m = 0; m < 4; ++m)
#pragma unroll
                        for (int n = 0; n < 2; ++n) acc[a][b][m][n] = (f32x4){0.f, 0.f, 0.f, 0.f};
        }
        cA = nA; cB = nB; pac = pan; pbc = pbn; nt = ntn; ++ui;
        if (wr == 1) PG8_BAR;
    }
    PG8_WAIT_V(0);
    PG8_BAR;
#undef PG8_SA
#undef PG8_SB
#undef PG8_STAGE
#undef PG8_LDA
#undef PG8_LDB
#undef PG8_MMA
#undef PG8_WAIT_V
#undef PG8_WAIT_L
#undef PG8_BAR
#undef PG8_SCHED
}
}
using pg8::Unit;

struct Ctx {
    unsigned char* ws; int l, c;
    __device__ __forceinline__ bf16* W(size_t off) const { return (bf16*)(ws + WS_W) + (size_t)l * LW + off; }
    __device__ __forceinline__ bf16* buf(size_t off) const { return (bf16*)(ws + off); }
};

enum { G_MEMKV = 0, G_WIN, G_CHAIN, G_OUT, G_MQ, G_MO, G_UP, G_DOWN };

struct Gen {
    Ctx C; int type; int pm, pn;
    __device__ __forceinline__ bf16* pbuf(size_t off) const { return (bf16*)(C.ws + WS_R2 + (size_t)pm * PSTRIDE + off); }
    __device__ __forceinline__ bool punit(Unit& u, int ct, const bf16* A, unsigned pa, const bf16* B, unsigned pb, int nt, int kind, bf16* dst0, int ldc, float scale) const {
        u.A = (const char*)A; u.B = (const char*)B + (size_t)ct * 256 * pb; u.pa = pa; u.pb = pb; u.nt = nt; u.kind = kind; u.pm = pm; u.pn = ct; u.aux = 0;
        u.dst = dst0 ? (void*)(dst0 - (size_t)pm * 256 * ldc) : nullptr; u.ldc = ldc; u.scale = scale; return true;
    }
    __device__ __forceinline__ bool next(int i, Unit& u) const {
        const int G = gridDim.x, cb = blockIdx.x;
        const bf16* Hp = C.buf(WS_H) + (size_t)pm * 256 * 1024;
        switch (type) {
        case G_MEMKV: {
            const long L = (long)i * G + cb; if (L >= 64) return false;
            const int w = (int)L, seg = w >> 4, ll = seg >> 1, isv = seg & 1, j = w & 15;
            const bf16* Wkv = (const bf16*)(C.ws + WS_W) + (size_t)ll * LW + OW_MKV; const bf16* Hm = C.buf(WS_HM) + (size_t)ll * 2048 * 1024;
            u.pa = 2048; u.pb = 2048; u.nt = 16; u.kind = pg8::K_BF16; u.aux = 0; u.scale = 1.f;
            if (!isv) { u.pm = j >> 1; u.pn = j & 1; u.A = (const char*)(Hm + (size_t)u.pm * 256 * 1024); u.B = (const char*)(Wkv + (size_t)u.pn * 256 * 1024); u.dst = C.buf(WS_MEMK) + (size_t)ll * 2048 * 512; u.ldc = 512; }
            else { u.pm = j >> 3; u.pn = j & 7; u.A = (const char*)(Wkv + (size_t)(512 + u.pm * 256) * 1024); u.B = (const char*)(Hm + (size_t)u.pn * 256 * 1024); u.dst = C.buf(WS_MEMVT) + (size_t)ll * 512 * 2048; u.ldc = 2048; }
            return true; }
        case G_WIN: {
            const int total = 64 * 24 + 192; const long L = (long)i * G + cb; if (L >= total) return false;
            int w = pg8::xcd_remap((int)L, total);
            const bf16* H = C.buf(WS_H); const bf16* Win = C.W(OW_IN);
            u.pa = 2048; u.nt = 16; u.scale = 1.f; u.dst = nullptr; u.ldc = 0;
            if (w < 1536) { int tm, tn; pg8::pmpn(w, 64, 24, tm, tn); const int tile = tn < 12 ? tn : tn + 3;
                u.A = (const char*)(H + (size_t)tm * 256 * 1024); u.B = (const char*)(Win + (size_t)tile * 256 * 1024); u.pb = 2048; u.pm = tm;
                if (tile < 6) { u.kind = pg8::K_BF16; u.pn = tile; u.dst = C.buf(WS_UABC); u.ldc = 1536; u.aux = 0; }
                else if (tile < 9) { u.kind = pg8::K_Q; u.pn = tile - 6; u.aux = tile - 6; }
                else if (tile < 12) { u.kind = pg8::K_K; u.pn = tile - 9; u.aux = tile - 9; }
                else { u.kind = pg8::K_GATE; u.pn = tile - 15; u.dst = C.buf(WS_G); u.ldc = 3072; u.aux = 0; }
            } else { w -= 1536; const int g = w >> 6, tn = w & 63, bl = tn >> 4, p0 = 256 * (tn & 15), sh = 2 * g, Ld = S >> sh, r = p0 / Ld, i0 = p0 % Ld, s0 = r + (i0 << sh);
                u.A = (const char*)(Win + (size_t)(3072 + 256 * g) * 1024); u.B = (const char*)(H + (size_t)(bl * S + s0) * 1024); u.pb = 2048u << sh;
                u.kind = pg8::K_VT; u.pm = g; u.pn = tn; u.aux = g; }
            return true; }
        case G_CHAIN: { if (i >= 3) return false;
            const int koff = i * 384;
            punit(u, pn, pbuf(PO_XCAT) + koff, 2048, C.W(OW_CAT) + koff, 2048, i < 2 ? 6 : 4, pg8::K_CH0 + i, pbuf(PO_MERGED), 1024, 1.f); u.aux = i; return true; }
        case G_OUT: return i == 0 && punit(u, pn, pbuf(PO_MERGED), 2048, C.W(OW_OUT), 2048, 16, pg8::K_F32, nullptr, 1024, 1.f);
        case G_MQ: return i == 0 && pn < 2 && punit(u, pn, Hp, 2048, C.W(OW_MQ), 2048, 16, pg8::K_BF16, pbuf(PO_QM), 512, 0.08838834764831845f * LOG2E);
        case G_MO: return i == 0 && punit(u, pn, pbuf(PO_OM), 1024, C.W(OW_MO), 1024, 8, pg8::K_F32, nullptr, 1024, 1.f);
        case G_UP: { const int ct = pn + 4 * i; return ct < 22 && punit(u, ct, Hp, 2048, C.W(OW_UP), 2048, 16, pg8::K_BF16, pbuf(PO_Z), DFF, 1.f); }
        default: return i == 0 && punit(u, pn, pbuf(PO_Z), 5632, C.W(OW_DOWN), 5632, 44, pg8::K_F32, nullptr, 1024, 1.f);
        }
    }
};

__device__ __forceinline__ void panel_exchange(unsigned* cnt) {
    asm volatile("s_waitcnt vmcnt(0)" ::: "memory");
    __syncthreads();
    if (threadIdx.x == 0) {
        __hip_atomic_fetch_add(cnt, 1u, __ATOMIC_RELAXED, __HIP_MEMORY_SCOPE_AGENT);
        unsigned sp = 0;
        while (__hip_atomic_load(cnt, __ATOMIC_RELAXED, __HIP_MEMORY_SCOPE_AGENT) < 4u) { __builtin_amdgcn_s_sleep(1); if (++sp > (1u << 24)) break; }
    }
    __syncthreads();
}
template <int MODE> struct Epi {
    Ctx C;
    const void* xsrc; void* xout; const float* gpost; const float* gpre; unsigned char* inst; unsigned* cnts; LAS unsigned char* ldsx; int dstf32;
    __device__ __forceinline__ bool operator()(f32x4 (&acc)[2][2][4][2], const Unit& u, int wr, int wc, int fr, int fq) const {
        const int rl0 = wr * 64 + fr, cl0 = wc * 32 + 8 * fq;
        if (MODE == 4) {
            LAS float* Hl = (LAS float*)ldsx;
            const float* cw = gpost; bf16* Z = (bf16*)u.dst;
            float* RAWL = (float*)(C.ws + WS_RAW); float* RAWF = RAWL + 64 * 2 * DFF;
            const int clane = wc * 32 + 8 * fq, lane = fq * 16 + fr;
#pragma unroll
            for (int ai = 0; ai < 2; ++ai) if (fr >= 14) { LAS float* d = Hl + ((ai * 2 + wr) * 2 + (fr - 14)) * 128 + clane; *(LAS f32x4*)d = acc[ai][0][3][0]; *(LAS f32x4*)(d + 4) = acc[ai][0][3][1]; }
            if (wr == 1 && fr >= 14) { float* d = RAWL + ((size_t)u.pm * 2 + (fr - 14)) * DFF + u.pn * 128 + clane; *(f32x4*)d = acc[1][0][3][0]; *(GAS f32x4*)(d + 4) = acc[1][0][3][1]; }
            if (wr == 0 && fr < 2) { float* d = RAWF + ((size_t)u.pm * 2 + fr) * (2 * DFF) + u.pn * 128 + clane;
                *(f32x4*)d = acc[0][0][0][0]; *(GAS f32x4*)(d + 4) = acc[0][0][0][1]; *(GAS f32x4*)(d + DFF) = acc[0][1][0][0]; *(GAS f32x4*)(d + DFF + 4) = acc[0][1][0][1]; }
            asm volatile("s_waitcnt lgkmcnt(0)" ::: "memory"); __syncthreads();
            f32x4 w[3][2];
#pragma unroll
            for (int j = 0; j < 3; ++j)
#pragma unroll
                for (int n = 0; n < 2; ++n) w[j][n] = *(const GAS f32x4*)(cw + j * DFF + u.pn * 128 + clane + 4 * n);
            const int src1 = (lane & 48) | ((lane - 1) & 15), src2 = (lane & 48) | ((lane - 2) & 15);
#pragma unroll
            for (int ai = 0; ai < 2; ++ai) {
                const int strip = ai * 2 + wr;
                f32x4 p1[2], p2[2];
#pragma unroll
                for (int n = 0; n < 2; ++n) { p1[n] = (f32x4){0.f, 0.f, 0.f, 0.f}; p2[n] = p1[n];
                    if (strip > 0) { const LAS float* hs = Hl + ((strip - 1) * 2) * 128 + clane + 4 * n; p2[n] = *(const LAS f32x4*)hs; p1[n] = *(const LAS f32x4*)(hs + 128); } }
#pragma unroll
                for (int m = 0; m < 4; ++m) {
                    bf16* zp = Z + (size_t)(u.pm * 256 + ai * 128 + m * 16 + rl0) * DFF + u.pn * 128 + clane;
                    float o[8];
#pragma unroll
                    for (int n = 0; n < 2; ++n) {
                        const f32x4 cur = acc[ai][0][m][n], ub = acc[ai][1][m][n]; f32x4 r1, r2;
#pragma unroll
                        for (int e = 0; e < 4; ++e) { r1[e] = __shfl(cur[e], src1); r2[e] = __shfl(cur[e], src2); }
                        const f32x4 pv1 = (fr >= 1) ? r1 : p1[n], pv2 = (fr >= 2) ? r2 : (fr == 1 ? p1[n] : p2[n]);
                        const f32x4 a = w[0][n] * pv2 + w[1][n] * pv1 + w[2][n] * cur;
#pragma unroll
                        for (int e = 0; e < 4; ++e) o[4 * n + e] = a[e] * __builtin_amdgcn_rcpf(1.f + __builtin_amdgcn_exp2f(-LOG2E * a[e])) * ub[e];
                        p1[n] = (fr == 0) ? r1 : r2; p2[n] = r2;
                    }
                    *(u32x4*)zp = pack8(o);
                }
            }
            return true;
        }
        if (MODE == 3) {
            float* slot1 = (float*)inst; float* slot2 = slot1 + 16384 * 4; unsigned* cnt1 = cnts; unsigned* cnt2 = cnts + 64;
            LAS float* P = (LAS float*)(ldsx); LAS float* Sx = P + 1024;
            const int row0 = u.pm * 256 + rl0, col0 = u.pn * 256 + cl0, tid = (wr * 4 + wc) * 64 + fq * 16 + fr;
            bf16* H = C.buf(WS_H);
#pragma unroll
            for (int ai = 0; ai < 2; ++ai)
#pragma unroll
                for (int m = 0; m < 4; ++m) { float sq = 0.f;
#pragma unroll
                    for (int bj = 0; bj < 2; ++bj)
#pragma unroll
                        for (int n = 0; n < 2; ++n) { const f32x4 v = acc[ai][bj][m][n]; sq += v[0] * v[0] + v[1] * v[1] + v[2] * v[2] + v[3] * v[3]; }
                    sq += __shfl_xor(sq, 16); sq += __shfl_xor(sq, 32);
                    if (fq == 0) P[(ai * 128 + m * 16 + rl0) * 4 + wc] = sq; }
            asm volatile("s_waitcnt lgkmcnt(0)" ::: "memory"); __syncthreads();
            if (tid < 256) { const float tot = (P[tid * 4 + 0] + P[tid * 4 + 1]) + (P[tid * 4 + 2] + P[tid * 4 + 3]);
                __hip_atomic_store(slot1 + (size_t)(u.pm * 256 + tid) * 4 + u.pn, tot, __ATOMIC_RELAXED, __HIP_MEMORY_SCOPE_AGENT); }
            const size_t gbase = ((size_t)C.c * TC + u.pm * 256 + rl0) * 1024 + col0;
            const bf16* xs = (const bf16*)xsrc;
            f32x4 gpv[2][2];
#pragma unroll
            for (int bj = 0; bj < 2; ++bj) { gpv[bj][0] = *(const GAS f32x4*)(gpost + col0 + bj * 128); gpv[bj][1] = *(const GAS f32x4*)(gpost + col0 + bj * 128 + 4); }
            u32x4 pre[4][2];
#pragma unroll
            for (int m = 0; m < 4; ++m)
#pragma unroll
                for (int bj = 0; bj < 2; ++bj) pre[m][bj] = *(const GAS u32x4*)(xs + gbase + (size_t)(m * 16) * 1024 + bj * 128);
            panel_exchange(cnt1 + u.pm);
            if (tid < 256) { const float* sl = slot1 + (size_t)(u.pm * 256 + tid) * 4;
                const float a0 = __hip_atomic_load(sl + 0, __ATOMIC_RELAXED, __HIP_MEMORY_SCOPE_AGENT), a1 = __hip_atomic_load(sl + 1, __ATOMIC_RELAXED, __HIP_MEMORY_SCOPE_AGENT),
                            a2 = __hip_atomic_load(sl + 2, __ATOMIC_RELAXED, __HIP_MEMORY_SCOPE_AGENT), a3 = __hip_atomic_load(sl + 3, __ATOMIC_RELAXED, __HIP_MEMORY_SCOPE_AGENT);
                Sx[tid] = 1.f / sqrtf(((a0 + a1) + (a2 + a3)) * (1.f / 1024.f) + EPS); }
            asm volatile("s_waitcnt lgkmcnt(0)" ::: "memory"); __syncthreads();
#pragma unroll
            for (int ai = 0; ai < 2; ++ai)
#pragma unroll
                for (int m = 0; m < 4; ++m) { const int rl = ai * 128 + m * 16 + rl0;
                    const float rs = Sx[rl];
                    const size_t go = gbase + (size_t)(ai * 128 + m * 16) * 1024; float sq = 0.f;
#pragma unroll
                    for (int bj = 0; bj < 2; ++bj) {
                        const f32x4 gp0 = gpv[bj][0], gp1 = gpv[bj][1]; const u32x4 xw = pre[m][bj];
                        const f32x4 xv0 = {bflo(xw.x), bfhi(xw.x), bflo(xw.y), bfhi(xw.y)}, xv1 = {bflo(xw.z), bfhi(xw.z), bflo(xw.w), bfhi(xw.w)};
                        if (ai == 0) pre[m][bj] = *(const GAS u32x4*)(xs + go + (size_t)128 * 1024 + bj * 128);
                        const f32x4 v0 = xv0 + acc[ai][bj][m][0] * rs * gp0, v1 = xv1 + acc[ai][bj][m][1] * rs * gp1;
                        if (dstf32) { *(GAS f32x4*)((float*)xout + go + bj * 128) = v0; *(GAS f32x4*)((float*)xout + go + bj * 128 + 4) = v1; }
                        else { u32x4 w; w.x = pk2(v0[0], v0[1]); w.y = pk2(v0[2], v0[3]); w.z = pk2(v1[0], v1[1]); w.w = pk2(v1[2], v1[3]); *(GAS u32x4*)((bf16*)xout + go + bj * 128) = w; }
                        acc[ai][bj][m][0] = v0; acc[ai][bj][m][1] = v1;
                        sq += v0[0] * v0[0] + v0[1] * v0[1] + v0[2] * v0[2] + v0[3] * v0[3] + v1[0] * v1[0] + v1[1] * v1[1] + v1[2] * v1[2] + v1[3] * v1[3]; }
                    if (gpre) { sq += __shfl_xor(sq, 16); sq += __shfl_xor(sq, 32); if (fq == 0) P[rl * 4 + wc] = sq; } }
            if (gpre) {
                asm volatile("s_waitcnt lgkmcnt(0)" ::: "memory"); __syncthreads();
                if (tid < 256) { const float tot = (P[tid * 4 + 0] + P[tid * 4 + 1]) + (P[tid * 4 + 2] + P[tid * 4 + 3]);
                    __hip_atomic_store(slot2 + (size_t)(u.pm * 256 + tid) * 4 + u.pn, tot, __ATOMIC_RELAXED, __HIP_MEMORY_SCOPE_AGENT); }
                f32x4 gqv[2][2];
#pragma unroll
                for (int bj = 0; bj < 2; ++bj) { gqv[bj][0] = *(const GAS f32x4*)(gpre + col0 + bj * 128); gqv[bj][1] = *(const GAS f32x4*)(gpre + col0 + bj * 128 + 4); }
                panel_exchange(cnt2 + u.pm);
                if (tid < 256) { const float* sl = slot2 + (size_t)(u.pm * 256 + tid) * 4;
                    const float a0 = __hip_atomic_load(sl + 0, __ATOMIC_RELAXED, __HIP_MEMORY_SCOPE_AGENT), a1 = __hip_atomic_load(sl + 1, __ATOMIC_RELAXED, __HIP_MEMORY_SCOPE_AGENT),
                                a2 = __hip_atomic_load(sl + 2, __ATOMIC_RELAXED, __HIP_MEMORY_SCOPE_AGENT), a3 = __hip_atomic_load(sl + 3, __ATOMIC_RELAXED, __HIP_MEMORY_SCOPE_AGENT);
                    Sx[tid] = 1.f / sqrtf(((a0 + a1) + (a2 + a3)) * (1.f / 1024.f) + EPS); }
                asm volatile("s_waitcnt lgkmcnt(0)" ::: "memory"); __syncthreads();
#pragma unroll
                for (int ai = 0; ai < 2; ++ai)
#pragma unroll
                    for (int m = 0; m < 4; ++m) { const int rl = ai * 128 + m * 16 + rl0, r = u.pm * 256 + rl;
                        const float rs = Sx[rl];
#pragma unroll
                        for (int bj = 0; bj < 2; ++bj) { const f32x4 g0 = gqv[bj][0], g1 = gqv[bj][1];
                            const f32x4 v0 = acc[ai][bj][m][0] * rs * g0, v1 = acc[ai][bj][m][1] * rs * g1;
                            u32x4 w; w.x = pk2(v0[0], v0[1]); w.y = pk2(v0[2], v0[3]); w.z = pk2(v1[0], v1[1]); w.w = pk2(v1[2], v1[3]);
                            *(GAS u32x4*)(H + (size_t)r * 1024 + col0 + bj * 128) = w; } }
            }
            return true;
        }
        int kind = u.kind;
        if (MODE == 0 && kind != pg8::K_F32) kind = pg8::K_BF16;
        if (MODE == 2) kind = pg8::K_CH0;
        if (MODE == 1 && (kind == pg8::K_F32 || kind > pg8::K_VT)) kind = pg8::K_BF16;
        switch (kind) {
        case pg8::K_BF16: {
            bf16* base = (bf16*)u.dst + (size_t)(u.pm * 256 + rl0) * u.ldc + u.pn * 256 + cl0; const float sc = u.scale;
#pragma unroll
            for (int ai = 0; ai < 2; ++ai)
#pragma unroll
                for (int m = 0; m < 4; ++m) { bf16* rowp = base + (size_t)(ai * 128 + m * 16) * u.ldc;
#pragma unroll
                    for (int bj = 0; bj < 2; ++bj) { const f32x4 v0 = acc[ai][bj][m][0] * sc, v1 = acc[ai][bj][m][1] * sc;
                        u32x4 w; w.x = pk2(v0[0], v0[1]); w.y = pk2(v0[2], v0[3]); w.z = pk2(v1[0], v1[1]); w.w = pk2(v1[2], v1[3]);
                        *(GAS u32x4*)(rowp + bj * 128) = w; } }
            return true; }
        case pg8::K_F32: { if (MODE != 0) return true;
            float* base = (float*)u.dst + (size_t)(u.pm * 256 + rl0) * u.ldc + u.pn * 256 + cl0;
#pragma unroll
            for (int ai = 0; ai < 2; ++ai)
#pragma unroll
                for (int m = 0; m < 4; ++m) { float* rowp = base + (size_t)(ai * 128 + m * 16) * u.ldc;
#pragma unroll
                    for (int bj = 0; bj < 2; ++bj) { *(GAS f32x4*)(rowp + bj * 128) = acc[ai][bj][m][0]; *(GAS f32x4*)(rowp + bj * 128 + 4) = acc[ai][bj][m][1]; } }
            return true; }
        case pg8::K_GATE: { if (MODE != 1) return true;
            bf16* base = (bf16*)u.dst + ((size_t)(u.pm * 12 + u.pn) * 16 * 8 + (wr * 4 + wc)) * 512 + (fq * 16 + fr) * 8;
#pragma unroll
            for (int ai = 0; ai < 2; ++ai)
#pragma unroll
                for (int m = 0; m < 4; ++m)
#pragma unroll
                    for (int bj = 0; bj < 2; ++bj) { float f[8];
#pragma unroll
                        for (int e = 0; e < 8; ++e) { const float v = acc[ai][bj][m][e >> 2][e & 3]; f[e] = fmaxf(__builtin_amdgcn_rcpf(1.f + __builtin_amdgcn_exp2f(-LOG2E * v)), 1e-20f); }
                        *(GAS u32x4*)(base + (size_t)((ai * 4 + m) * 2 + bj) * 8 * 512) = pack8(f); }
            return true; }
        case pg8::K_Q: case pg8::K_K: { if (MODE != 1) return true;
            const int g = u.aux, sh = 2 * g, Ld = S >> sh;
            bf16* dstb = C.buf(u.kind == pg8::K_Q ? WS_QP : WS_KP);
            const float* cs = (const float*)(C.ws + WS_CS);
            const float sc = (u.kind == pg8::K_Q) ? 0.125f * LOG2E : 1.f;
            const bool rot = ((wc & 1) == 0);
#pragma unroll
            for (int ai = 0; ai < 2; ++ai)
#pragma unroll
                for (int m = 0; m < 4; ++m) {
                    const int rloc = u.pm * 256 + ai * 128 + m * 16 + rl0;
                    const int bl = rloc >> 12, s = rloc & 4095, pos = (s & ((1 << sh) - 1)) * Ld + (s >> sh);
                    const float* csr = cs + (size_t)(C.c * TC + rloc) * 16;
                    f32x4 c0 = {1.f, 1.f, 1.f, 1.f}, c1 = c0, s0 = {0.f, 0.f, 0.f, 0.f}, s1 = s0;
                    if (rot) { const float* csq = csr + ((fq & 1) ? 0 : 0);
                        const f32x4 t0 = *(const GAS f32x4*)(csq), t1 = *(const GAS f32x4*)(csq + 4), t2 = *(const GAS f32x4*)(csq + 8), t3 = *(const GAS f32x4*)(csq + 12);
                        const bool act = fq < 2; const float sg = act ? ((fq == 0) ? -1.f : 1.f) : 0.f;
#pragma unroll
                        for (int e = 0; e < 4; ++e) { c0[e] = act ? t0[e] : 1.f; c1[e] = act ? t1[e] : 1.f; s0[e] = t2[e] * sg; s1[e] = t3[e] * sg; } }
#pragma unroll
                    for (int bj = 0; bj < 2; ++bj) {
                        f32x4 v0 = acc[ai][bj][m][0], v1 = acc[ai][bj][m][1];
                        if (rot) {
                            f32x4 o0, o1;
#pragma unroll
                            for (int e = 0; e < 4; ++e) { o0[e] = __shfl_xor(v0[e], 16); o1[e] = __shfl_xor(v1[e], 16); }
                            v0 = v0 * c0 + o0 * s0; v1 = v1 * c1 + o1 * s1;
                        }
                        v0 = v0 * sc; v1 = v1 * sc;
                        const int head = 4 * g + 2 * bj + (wc >> 1), dim = 32 * (wc & 1) + 8 * fq;
                        u32x4 w; w.x = pk2(v0[0], v0[1]); w.y = pk2(v0[2], v0[3]); w.z = pk2(v1[0], v1[1]); w.w = pk2(v1[2], v1[3]);
                        *(GAS u32x4*)(dstb + ((size_t)(bl * 12 + head) * S + pos) * 64 + dim) = w;
                    }
                }
            return true; }
        case pg8::K_VT: { if (MODE != 1) return true;
            const int g = u.aux, bl = u.pn >> 4, p0 = 256 * (u.pn & 15);
            bf16* dstb = C.buf(WS_VT);
#pragma unroll
            for (int ai = 0; ai < 2; ++ai)
#pragma unroll
                for (int m = 0; m < 4; ++m) { const int r = ai * 128 + m * 16 + rl0;
                    bf16* rowp = dstb + ((size_t)(bl * 12 + 4 * g + (r >> 6)) * 128 + ((p0 + cl0) >> 5)) * 2048 + (r & 63) * 32 + ((p0 + cl0) & 31);
#pragma unroll
                    for (int bj = 0; bj < 2; ++bj) { const f32x4 v0 = acc[ai][bj][m][0], v1 = acc[ai][bj][m][1];
                        u32x4 w; w.x = pk2(v0[0], v0[1]); w.y = pk2(v0[2], v0[3]); w.z = pk2(v1[0], v1[1]); w.w = pk2(v1[2], v1[3]);
                        *(GAS u32x4*)(rowp + bj * 4 * 2048) = w; } }
            return true; }
        default: { if (MODE != 2) return true;
            const int sub = u.aux;
            const bf16* gb = C.buf(WS_G) + ((size_t)(u.pm * 12 + 4 * sub + u.pn) * 16 * 8 + (wr * 4 + wc)) * 512 + (fq * 16 + fr) * 8;
            constexpr size_t GT = (size_t)4 * 16 * 8 * 512;
            bf16* ob = (bf16*)u.dst + (size_t)(u.pm * 256 + rl0) * 1024 + u.pn * 256 + cl0;
#pragma unroll
            for (int ai = 0; ai < 2; ++ai) {
                u32x4 gav[4][2], gnv[4][2];
#pragma unroll
                for (int m = 0; m < 4; ++m)
#pragma unroll
                    for (int bj = 0; bj < 2; ++bj) { const size_t co = (size_t)((ai * 4 + m) * 2 + bj) * 8 * 512;
                        gav[m][bj] = *(const GAS u32x4*)(gb + co); if (sub < 2) gnv[m][bj] = *(const GAS u32x4*)(gb + co + GT); }
#pragma unroll
                for (int m = 0; m < 4; ++m) { const size_t ro = (size_t)(ai * 128 + m * 16);
#pragma unroll
                    for (int bj = 0; bj < 2; ++bj) {
                        float ga[8]; unpack8(gav[m][bj], ga);
                        if (sub < 2) { float gn[8]; unpack8(gnv[m][bj], gn);
#pragma unroll
                            for (int e = 0; e < 8; ++e) acc[ai][bj][m][e >> 2][e & 3] *= ga[e] * __builtin_amdgcn_rcpf(gn[e]);
                        } else { float f[8];
#pragma unroll
                            for (int e = 0; e < 8; ++e) f[e] = acc[ai][bj][m][e >> 2][e & 3] * ga[e];
                            *(GAS u32x4*)(ob + ro * 1024 + bj * 128) = pack8(f); }
                    } }
            }
            return sub == 2; }
        }
    }
};

__device__ __forceinline__ void transpose_item(const float* W, int N, bf16* WT, int ldk, int koff, LAS float* scr, int item, int lane, bool upmap = false) {
    const int nblk = N / 32, kb = item / nblk, nb = item % nblk, k0 = 64 * kb, n0 = 32 * nb;
    const int r0 = !upmap ? n0 : (n0 < DFF ? (n0 >> 7) * 256 + (n0 & 127) : ((n0 - DFF) >> 7) * 256 + 128 + ((n0 - DFF) & 127));
#pragma unroll 8
    for (int i = 0; i < 32; ++i) { const int kk = 2 * i + (lane >> 5); scr[kk * 33 + (lane & 31)] = W[(size_t)(k0 + kk) * N + n0 + (lane & 31)]; }
    asm volatile("s_waitcnt lgkmcnt(0)" ::: "memory");
    const int c = lane & 7;
#pragma unroll
    for (int j = 0; j < 4; ++j) { const int n = (lane >> 3) + 8 * j; const LAS float* s = scr + (8 * c) * 33 + n;
        u32x4 o; o.x = pk2(s[0 * 33], s[1 * 33]); o.y = pk2(s[2 * 33], s[3 * 33]); o.z = pk2(s[4 * 33], s[5 * 33]); o.w = pk2(s[6 * 33], s[7 * 33]);
        *(GAS u32x4*)(WT + (size_t)(r0 + n) * ldk + koff + k0 + 8 * c) = o; }
    asm volatile("s_waitcnt lgkmcnt(0)" ::: "memory");
}

__device__ __forceinline__ void init_phase(const Params& p, LAS unsigned char* lds) {
    const int tid = otid(), lane = tid & 63, wave = tid >> 6;
    const int gw = blockIdx.x * NWAVES + wave, NGW = gridDim.x * NWAVES;
    const int gt = blockIdx.x * NTHREADS + tid, NGT = gridDim.x * NTHREADS;
    LAS float* scr = (LAS float*)(lds + wave * 16384);
    constexpr int I_IN = 16 * 216, I_B = 6 * 32, I_C = 4 * 32, I_OUT = 16 * 32, I_MQ = 16 * 16, I_MKV = 16 * 32, I_MO = 8 * 32, I_UP = 16 * 176, I_DN = 44 * 32;
    constexpr int I_LAYER = I_IN + I_B + I_C + I_OUT + I_MQ + I_MKV + I_MO + I_UP + I_DN;
    for (int it = gw; it < 2 * I_LAYER; it += NGW) {
        const int l = it / I_LAYER; int r = it - l * I_LAYER;
        bf16* Wl = (bf16*)(p.ws + WS_W) + (size_t)l * LW;
        if (r < I_IN) { transpose_item(p.w_in + (size_t)l * 1024 * INW, INW, Wl + OW_IN, 1024, 0, scr, r, lane); continue; } r -= I_IN;
        if (r < I_B) { transpose_item(p.w_branch_b + (size_t)l * 384 * 1024, 1024, Wl + OW_CAT, 1024, 384, scr, r, lane); continue; } r -= I_B;
        if (r < I_C) { transpose_item(p.w_branch_c + (size_t)l * 256 * 1024, 1024, Wl + OW_CAT, 1024, 768, scr, r, lane); continue; } r -= I_C;
        if (r < I_OUT) { transpose_item(p.w_out + (size_t)l * 1024 * 1024, 1024, Wl + OW_OUT, 1024, 0, scr, r, lane); continue; } r -= I_OUT;
        if (r < I_MQ) { transpose_item(p.w_mq + (size_t)l * 1024 * 512, 512, Wl + OW_MQ, 1024, 0, scr, r, lane); continue; } r -= I_MQ;
        if (r < I_MKV) { transpose_item(p.w_mkv + (size_t)l * 1024 * 1024, 1024, Wl + OW_MKV, 1024, 0, scr, r, lane); continue; } r -= I_MKV;
        if (r < I_MO) { transpose_item(p.w_mo + (size_t)l * 512 * 1024, 1024, Wl + OW_MO, 512, 0, scr, r, lane); continue; } r -= I_MO;
        if (r < I_UP) { transpose_item(p.w_up + (size_t)l * 1024 * 5632, 5632, Wl + OW_UP, 1024, 0, scr, r, lane, true); continue; } r -= I_UP;
        transpose_item(p.w_down + (size_t)l * 2816 * 1024, 1024, Wl + OW_DOWN, 2816, 0, scr, r, lane);
    }
    for (int idx = gt; idx < 2 * 384 * 1024; idx += NGT) {
        const int l = idx / (384 * 1024), rem = idx - l * 384 * 1024, k = rem >> 10, n = rem & 1023, g = k / 96, cc = k - g * 96;
        const float* pw = p.pool_w + ((size_t)(l * 4 + g) * 96 + cc) * 96; const float* ps = p.pool_scale + l * 384 + g * 96; const float* wa = p.w_branch_a + ((size_t)l * 384 + g * 96) * 1024 + n;
        float a = 0.f;
        for (int d = 0; d < 96; ++d) a += pw[d] * ps[d] * wa[(size_t)d * 1024];
        ((bf16*)(p.ws + WS_W) + (size_t)l * LW + OW_CAT)[(size_t)n * 1024 + k] = (bf16)f2bf(a);
    }
    for (int idx = gt; idx < NB * S * 8; idx += NGT) {
        const int tok = idx >> 3, i = idx & 7;
        const float inv = __builtin_exp2f(-(float)i * (18.931568569324174f / 8.0f)), ang = (float)p.positions[tok] * inv;
        double rv = (double)ang * 0.15915494309189535; rv -= __builtin_floor(rv);
        const float sn = __builtin_amdgcn_sinf((float)rv), cn = __builtin_amdgcn_cosf((float)rv);
        float* cs = (float*)(p.ws + WS_CS) + (size_t)tok * 16; cs[i] = cn; cs[8 + i] = sn;
    }
    for (int rr = gw; rr < 2 * 2048; rr += NGW) {
        const int l = rr >> 11, row = rr & 2047;
        const f32x4* xr = (const f32x4*)(p.mem + (size_t)row * 1024) + lane; const f32x4* gr = (const f32x4*)(p.norm_memkv + l * 1024) + lane;
        f32x4 v[4]; float ss = 0.f;
#pragma unroll
        for (int j = 0; j < 4; ++j) { v[j] = xr[64 * j]; ss += v[j].x * v[j].x + v[j].y * v[j].y + v[j].z * v[j].z + v[j].w * v[j].w; }
        const float rs = 1.f / sqrtf(wave_sum(ss) * (1.f / 1024.f) + EPS);
        u32x2* o = (u32x2*)((bf16*)(p.ws + WS_HM) + ((size_t)l * 2048 + row) * 1024) + lane;
#pragma unroll
        for (int j = 0; j < 4; ++j) { const f32x4 gg = gr[64 * j]; u32x2 w; w.x = pk2(v[j].x * rs * gg.x, v[j].y * rs * gg.y); w.y = pk2(v[j].z * rs * gg.z, v[j].w * rs * gg.w); o[64 * j] = w; }
    }
}

__device__ __forceinline__ void prenorm_rows(const Params& p, int c, int pm, int pn) {
    const int tid = otid(), lane = tid & 63, wave = tid >> 6;
    bf16* H = (bf16*)(p.ws + WS_H);
    for (int k = 0; k < 8; ++k) {
        const int row = pm * 256 + pn * 64 + wave + 8 * k; const size_t grow = (size_t)c * TC + row;
        const f32x4* xr = (const f32x4*)(p.x + grow * 1024) + lane; const f32x4* gr = (const f32x4*)p.norm_mix_pre + lane;
        f32x4 v[4]; float ss = 0.f;
#pragma unroll
        for (int j = 0; j < 4; ++j) { v[j] = xr[64 * j]; ss += v[j].x * v[j].x + v[j].y * v[j].y + v[j].z * v[j].z + v[j].w * v[j].w; }
        const float rs = 1.f / sqrtf(wave_sum(ss) * (1.f / 1024.f) + EPS);
        u32x2* o = (u32x2*)(H + (size_t)row * 1024) + lane; u32x2* o16 = (u32x2*)((bf16*)(p.ws + WS_X16) + grow * 1024) + lane;
#pragma unroll
        for (int j = 0; j < 4; ++j) { const f32x4 gg = gr[64 * j]; u32x2 w; w.x = pk2(v[j].x * rs * gg.x, v[j].y * rs * gg.y); w.y = pk2(v[j].z * rs * gg.z, v[j].w * rs * gg.w); o[64 * j] = w;
            u32x2 xw; xw.x = pk2(v[j].x, v[j].y); xw.y = pk2(v[j].z, v[j].w); o16[64 * j] = xw; }
    }
}

template <int W> __device__ __forceinline__ void pool_item(const bf16* U, bf16* X, int row, int s, int c0) {
    float sum[8] = {0.f, 0.f, 0.f, 0.f, 0.f, 0.f, 0.f, 0.f};
    u32x4 v[W];
#pragma unroll
    for (int j = 0; j < W; ++j) v[j] = (s - j >= 0) ? *(const GAS u32x4*)(U + (size_t)(row - j) * 1536 + c0) : (u32x4){0u, 0u, 0u, 0u};
    u32x4 nx[3], ox[3];
#pragma unroll
    for (int k = 1; k < 4; ++k) { nx[k - 1] = *(const GAS u32x4*)(U + (size_t)(row + k) * 1536 + c0);
        ox[k - 1] = (s + k - W >= 0) ? *(const GAS u32x4*)(U + (size_t)(row + k - W) * 1536 + c0) : (u32x4){0u, 0u, 0u, 0u}; }
    float self[8]; unpack8(v[0], self);
#pragma unroll
    for (int j = 0; j < W; ++j) { float f[8]; unpack8(v[j], f);
#pragma unroll
        for (int e = 0; e < 8; ++e) sum[e] += f[e]; }
#pragma unroll
    for (int k = 0; k < 4; ++k) {
        if (k > 0) { float fn[8], fo[8]; unpack8(nx[k - 1], fn); unpack8(ox[k - 1], fo);
#pragma unroll
            for (int e = 0; e < 8; ++e) { sum[e] += fn[e] - fo[e]; self[e] = fn[e]; } }
        const int cnt = (s + k + 1) < W ? (s + k + 1) : W; const float ic = 1.f / (float)cnt; float o[8];
#pragma unroll
        for (int e = 0; e < 8; ++e) o[e] = sum[e] * ic - self[e];
        *(GAS u32x4*)(X + (size_t)(row + k) * 1024 + c0) = pack8(o); }
}
__device__ __forceinline__ void poolconv_phase(const Params& p, int l, int pm, int pn) {
    const int gt = otid(), NGT = NTHREADS;
    const bf16* U = (const bf16*)(p.ws + WS_UABC); bf16* X = (bf16*)(p.ws + WS_R2 + (size_t)pm * PSTRIDE + PO_XCAT) - (size_t)pm * 256 * 1024;
    const float* cw = p.conv_b_w + (size_t)l * 3 * 384;
    const int lane_ = gt & 63, wave_ = gt >> 6; (void)NGT;
    for (int kk = 0; kk < 3; ++kk) {
        const int wi = __builtin_amdgcn_readfirstlane(kk * 8 + wave_);
        if (wi < 12) {
            const int g = wi / 3, j = (wi - 3 * g) * 64 + lane_, rg = j / 12, ci = j - rg * 12, row = pm * 256 + pn * 64 + rg * 4, s = row & 4095, c0 = (g * 12 + ci) * 8;
            if (g == 0) pool_item<2>(U, X, row, s, c0); else if (g == 1) pool_item<4>(U, X, row, s, c0); else if (g == 2) pool_item<8>(U, X, row, s, c0); else pool_item<16>(U, X, row, s, c0);
        } else {
            const int j = (wi - 12) * 64 + lane_, rg = j / 48, it = 48 + (j - rg * 48), row = pm * 256 + pn * 64 + rg * 4, s = row & 4095;
            const int c0 = (it - 48) * 8;
            u32x4 bx[6], bc[6], bb[4];
#pragma unroll
            for (int j = 0; j < 6; ++j) { const bool ok = (j >= 2 || s > 0);
                bx[j] = ok ? *(const GAS u32x4*)(U + (size_t)(row - 2 + j) * 1536 + 384 + c0) : (u32x4){0u, 0u, 0u, 0u};
                bc[j] = ok ? *(const GAS u32x4*)(U + (size_t)(row - 2 + j) * 1536 + 1152 + c0) : (u32x4){0u, 0u, 0u, 0u}; }
#pragma unroll
            for (int j = 0; j < 4; ++j) bb[j] = *(const GAS u32x4*)(U + (size_t)(row + j) * 1536 + 768 + c0);
            float w[3][8];
#pragma unroll
            for (int j = 0; j < 3; ++j) { const f32x4 w0 = *(const GAS f32x4*)(cw + j * 384 + c0), w1 = *(const GAS f32x4*)(cw + j * 384 + c0 + 4);
#pragma unroll
                for (int e = 0; e < 4; ++e) { w[j][e] = w0[e]; w[j][4 + e] = w1[e]; } }
            float pr[6][8];
#pragma unroll
            for (int j = 0; j < 6; ++j) { float fx[8], fc[8]; unpack8(bx[j], fx); unpack8(bc[j], fc);
#pragma unroll
                for (int e = 0; e < 8; ++e) pr[j][e] = fc[e] * fx[e]; }
#pragma unroll
            for (int k = 0; k < 4; ++k) { float g[8], o[8]; unpack8(bb[k], g);
#pragma unroll
                for (int e = 0; e < 8; ++e) o[e] = g[e] * (w[0][e] * pr[k][e] + w[1][e] * pr[k + 1][e] + w[2][e] * pr[k + 2][e]);
                *(GAS u32x4*)(X + (size_t)(row + k) * 1024 + 384 + c0) = pack8(o); }
        }
    }
}

__device__ __forceinline__ void ffnfix_local(const Params& p, int l, int pm) {
    const int tid = otid();
    const float* RAWL = (const float*)(p.ws + WS_RAW); const float* RAWF = RAWL + 64 * 2 * DFF; bf16* Z = (bf16*)(p.ws + WS_R2 + (size_t)pm * PSTRIDE + PO_Z);
    const float* cw = p.conv_ffn_w + (size_t)l * 3 * DFF;
    for (int ch = tid * 2; ch < DFF; ch += NTHREADS * 2) {
        float z0[2], z1[2];
#pragma unroll
        for (int e = 0; e < 2; ++e) { const int c = ch + e;
            const float um2 = RAWL[((size_t)(pm - 1) * 2 + 0) * DFF + c], um1 = RAWL[((size_t)(pm - 1) * 2 + 1) * DFF + c];
            const float u0 = RAWF[((size_t)pm * 2 + 0) * (2 * DFF) + c], u1 = RAWF[((size_t)pm * 2 + 1) * (2 * DFF) + c];
            const float b0 = RAWF[((size_t)pm * 2 + 0) * (2 * DFF) + DFF + c], b1 = RAWF[((size_t)pm * 2 + 1) * (2 * DFF) + DFF + c];
            const float w0 = cw[c], w1 = cw[DFF + c], w2 = cw[2 * DFF + c];
            const float a0 = w0 * um2 + w1 * um1 + w2 * u0, a1 = w0 * um1 + w1 * u0 + w2 * u1;
            z0[e] = a0 / (1.f + __expf(-a0)) * b0; z1[e] = a1 / (1.f + __expf(-a1)) * b1; }
        *(unsigned*)(Z + ch) = pk2(z0[0], z0[1]); *(unsigned*)(Z + DFF + ch) = pk2(z1[0], z1[1]);
    }
    asm volatile("s_waitcnt vmcnt(0)" ::: "memory"); __syncthreads();
}

template <int NQH>
__device__ __forceinline__ void dil_tile(unsigned char* ws, LAS unsigned char* lds, int pm, int slot, int g, int r, int i0, int l15, int g4) {
    const int sh = 2 * g, Ld = S >> sh, bl = pm >> 4, t0 = (pm & 15) * 256, head = 4 * g + slot;
    const bf16* Qb = (const bf16*)(ws + WS_QP) + ((size_t)(bl * 12 + head) * S + (size_t)r * Ld + i0) * 64;
    const bf16* Kb = (const bf16*)(ws + WS_KP) + ((size_t)(bl * 12 + head) * S + (size_t)r * Ld) * 64;
    const bf16* Vb = (const bf16*)(ws + WS_VT) + ((size_t)(bl * 12 + head) * 128) * 2048;
    LAS float* Ob = (LAS float*)lds; LAS float* mb = Ob + 256 * 68; LAS float* lb = mb + 256;
    bf16* X = (bf16*)(ws + WS_R2 + (size_t)pm * PSTRIDE + PO_XCAT) - (size_t)pm * 256 * 1024;
    bf16x8 qf[NQH][2];
#pragma unroll
    for (int h = 0; h < NQH; ++h)
#pragma unroll
        for (int ks = 0; ks < 2; ++ks) qf[h][ks] = *(const GAS bf16x8*)(Qb + (16 * h + l15) * 64 + ks * 32 + g4 * 8);
    const int vp0 = r * Ld;
    bf16x8 vfa[2][5], vfb[2][5];
#define DIL_VLOAD(dst, dt0) _Pragma("unroll") for (int dt = 0; dt < 2; ++dt) _Pragma("unroll") for (int kb = 0; kb < 5; ++kb) { int pc = i0 - 128 + 32 * kb + 8 * g4; pc = pc < 0 ? 0 : (pc > Ld - 8 ? Ld - 8 : pc); \
        const int pos = vp0 + pc; dst[dt][kb] = *(const GAS bf16x8*)(Vb + (size_t)(pos >> 5) * 2048 + (16 * ((dt0) + dt) + l15) * 32 + (pos & 31)); }
    DIL_VLOAD(vfa, 0)
    f32x4 sc[NQH][5][2];
#pragma unroll
    for (int kb = 0; kb < 5; ++kb)
#pragma unroll
        for (int x = 0; x < 2; ++x) {
            const int kk = 32 * kb + 8 * (l15 >> 2) + 4 * x + (l15 & 3); int ik = i0 - 128 + kk; ik = ik < 0 ? 0 : (ik > Ld - 1 ? Ld - 1 : ik);
            const bf16x8 k0 = *(const GAS bf16x8*)(Kb + (size_t)ik * 64 + g4 * 8), k1 = *(const GAS bf16x8*)(Kb + (size_t)ik * 64 + 32 + g4 * 8);
#pragma unroll
            for (int h = 0; h < NQH; ++h) { f32x4 a = {0.f, 0.f, 0.f, 0.f};
                a = __builtin_amdgcn_mfma_f32_16x16x32_bf16(k0, qf[h][0], a, 0, 0, 0);
                a = __builtin_amdgcn_mfma_f32_16x16x32_bf16(k1, qf[h][1], a, 0, 0, 0);
                sc[h][kb][x] = a; }
        }
    DIL_VLOAD(vfb, 2)
#undef DIL_VLOAD
    float mxs[NQH], lss[NQH]; bf16x8 pf[NQH][5];
#pragma unroll
    for (int h = 0; h < NQH; ++h) {
        const int c = 16 * h + l15;
        float mx = -INFINITY;
#pragma unroll
        for (int kb = 0; kb < 5; ++kb)
#pragma unroll
            for (int x = 0; x < 2; ++x)
#pragma unroll
                for (int j = 0; j < 4; ++j) { const int kk = 32 * kb + 8 * g4 + 4 * x + j; const bool ok = (kk >= c) && (kk <= c + 128) && (i0 - 128 + kk >= 0);
                    const float v = ok ? sc[h][kb][x][j] : -INFINITY; sc[h][kb][x][j] = v; mx = fmaxf(mx, v); }
        mx = fmaxf(mx, __shfl_xor(mx, 16)); mx = fmaxf(mx, __shfl_xor(mx, 32));
        float ls = 0.f;
#pragma unroll
        for (int kb = 0; kb < 5; ++kb) { float f[8];
#pragma unroll
            for (int e = 0; e < 8; ++e) { f[e] = __builtin_amdgcn_exp2f(sc[h][kb][e >> 2][e & 3] - mx); ls += f[e]; }
            pf[h][kb] = __builtin_bit_cast(bf16x8, pack8(f)); }
        ls += __shfl_xor(ls, 16); ls += __shfl_xor(ls, 32);
        mxs[h] = mx; lss[h] = ls;
    }
#pragma unroll
    for (int h = 0; h < NQH; ++h) {
        const int c = 16 * h + l15; const float mx = mxs[h], ls = lss[h];
        f32x4 o[4];
#pragma unroll
        for (int dt = 0; dt < 4; ++dt) { o[dt] = (f32x4){0.f, 0.f, 0.f, 0.f};
#pragma unroll
            for (int kb = 0; kb < 5; ++kb) o[dt] = __builtin_amdgcn_mfma_f32_16x16x32_bf16(dt < 2 ? vfa[dt & 1][kb] : vfb[dt & 1][kb], pf[h][kb], o[dt], 0, 0, 0); }
        const int tl = (r + ((i0 + c) << sh)) - t0;
        LAS float* orow = Ob + tl * 68; const int rotc = 4 * (tl >> 4);
        if (g == 0) {
#pragma unroll
            for (int dt = 0; dt < 4; ++dt) *(LAS f32x4*)(orow + ((16 * dt + 4 * g4 + rotc) & 63)) = o[dt];
            if (g4 == 0) { mb[tl] = mx; lb[tl] = ls; }
        } else {
            const float mo = mb[tl], lo = lb[tl], mn = fmaxf(mo, mx), fa = exp2f(mo - mn), fb = exp2f(mx - mn), ln = fa * lo + fb * ls;
#pragma unroll
            for (int dt = 0; dt < 4; ++dt) { LAS f32x4* ptr = (LAS f32x4*)(orow + ((16 * dt + 4 * g4 + rotc) & 63)); o[dt] = (*ptr) * fa + o[dt] * fb; if (g == 1) *ptr = o[dt]; }
            if (g == 1) { if (g4 == 0) { mb[tl] = mn; lb[tl] = ln; } }
            else { const float il = 1.f / ln; bf16* xo = X + (size_t)(bl * S + t0 + tl) * 1024 + 768 + slot * 64 + 4 * g4;
#pragma unroll
                for (int dt = 0; dt < 4; ++dt) { u32x2 w; w.x = pk2(o[dt][0] * il, o[dt][1] * il); w.y = pk2(o[dt][2] * il, o[dt][3] * il); *(GAS u32x2*)(xo + 16 * dt) = w; } }
        }
    }
}
__device__ __forceinline__ void dilattn_phase(const Params& p, LAS unsigned char* lds, int pm, int pn) {
    const int tid = otid(), lane = tid & 63, wid = tid >> 6, l15 = lane & 15, g4 = lane >> 4;
    const int t0 = (pm & 15) * 256;
    __syncthreads();
    for (int g = 0; g < 3; ++g) {
        const int sh = 2 * g, tpr = 16 >> sh;
        if (g < 2) {
            const int qt = 2 * wid, r = qt / tpr, ib = qt - r * tpr, i0 = (t0 >> sh) + 16 * ib;
            dil_tile<2>(p.ws, lds, pm, pn, g, r, i0, l15, g4);
        } else {
#pragma unroll 1
            for (int qq = 0; qq < 2; ++qq) { const int qt = 2 * wid + qq, i0 = (t0 >> sh); dil_tile<1>(p.ws, lds, pm, pn, g, qt, i0, l15, g4); }
        }
        __syncthreads();
    }
}

__device__ __forceinline__ void memattn_phase(const Params& p, int l, int c, LAS unsigned char* lds, int pm, int pn) {
    const int tid = otid(), lane = tid & 63, wid = tid >> 6, l15 = lane & 15, g4 = lane >> 4;
    const bf16* QM = (const bf16*)(p.ws + WS_R2 + (size_t)pm * PSTRIDE + PO_QM) - (size_t)pm * 256 * 512; bf16* OM = (bf16*)(p.ws + WS_R2 + (size_t)pm * PSTRIDE + PO_OM) - (size_t)pm * 256 * 512;
    const bf16* MK = (const bf16*)(p.ws + WS_MEMK) + (size_t)l * 2048 * 512; const bf16* MV = (const bf16*)(p.ws + WS_MEMVT) + (size_t)l * 512 * 2048;
    constexpr int KP = 272, VP = 528, VOFF = 256 * KP;
    {
        const int bl = pm >> 4, head = pn, qb = pm & 15, b = c * BC + bl;
        __syncthreads();
        { u32x4 kv[8], vv[8];
#pragma unroll
        for (int i = 0; i < 8; ++i) { const int ch = tid + 512 * i, row = ch >> 4, c16 = ch & 15; kv[i] = *(const GAS u32x4*)(MK + (size_t)(b * 256 + row) * 512 + head * 128 + c16 * 8); }
#pragma unroll
        for (int i = 0; i < 8; ++i) { const int ch = tid + 512 * i, d = ch >> 5, k8 = ch & 31; vv[i] = *(const GAS u32x4*)(MV + (size_t)(head * 128 + d) * 2048 + b * 256 + k8 * 8); }
#pragma unroll
        for (int i = 0; i < 8; ++i) { const int ch = tid + 512 * i, row = ch >> 4, c16 = ch & 15; *(LAS u32x4*)(lds + row * KP + c16 * 16) = kv[i]; }
#pragma unroll
        for (int i = 0; i < 8; ++i) { const int ch = tid + 512 * i, d = ch >> 5, k8 = ch & 31, blk = k8 >> 2, kin = (k8 & 3) * 8; const u32x4 v = vv[i];
            const int p0 = (kin < 16) ? 8 * (kin >> 2) : 8 * ((kin - 16) >> 2) + 4, p1 = (kin + 4 < 16) ? 8 * ((kin + 4) >> 2) : 8 * ((kin + 4 - 16) >> 2) + 4;
            *(LAS u32x2*)(lds + VOFF + d * VP + (blk * 32 + p0) * 2) = (u32x2){v.x, v.y};
            *(LAS u32x2*)(lds + VOFF + d * VP + (blk * 32 + p1) * 2) = (u32x2){v.z, v.w}; } }
        asm volatile("s_waitcnt lgkmcnt(0)" ::: "memory"); __syncthreads();
        for (int qq = 0; qq < 2; ++qq) {
            const int row0 = bl * S + 256 * qb + 32 * wid + 16 * qq;
            bf16x8 qf[4];
#pragma unroll
            for (int ks = 0; ks < 4; ++ks) qf[ks] = *(const GAS bf16x8*)(QM + (size_t)(row0 + l15) * 512 + head * 128 + ks * 32 + g4 * 8);
            f32x4 o[8];
#pragma unroll
            for (int dt = 0; dt < 8; ++dt) o[dt] = (f32x4){0.f, 0.f, 0.f, 0.f};
            float mrun = -INFINITY, lrun = 0.f;
#pragma unroll 1
            for (int half = 0; half < 2; ++half) {
                f32x4 sc[4][2];
#pragma unroll
                for (int kb = 0; kb < 4; ++kb)
#pragma unroll
                    for (int x = 0; x < 2; ++x) { const int key = 128 * half + 32 * kb + 16 * x + l15;
                        const LAS unsigned char* kr = lds + key * KP + g4 * 16; f32x4 a = {0.f, 0.f, 0.f, 0.f};
#pragma unroll
                        for (int ks = 0; ks < 4; ++ks) a = __builtin_amdgcn_mfma_f32_16x16x32_bf16(*(const LAS bf16x8*)(kr + ks * 64), qf[ks], a, 0, 0, 0);
                        sc[kb][x] = a; }
                float mx = mrun;
#pragma unroll
                for (int kb = 0; kb < 4; ++kb)
#pragma unroll
                    for (int x = 0; x < 2; ++x)
#pragma unroll
                        for (int j = 0; j < 4; ++j) mx = fmaxf(mx, sc[kb][x][j]);
                mx = fmaxf(mx, __shfl_xor(mx, 16)); mx = fmaxf(mx, __shfl_xor(mx, 32));
                const float alpha = exp2f(mrun - mx); mrun = mx;
                float ls = 0.f; bf16x8 pf[4];
#pragma unroll
                for (int kb = 0; kb < 4; ++kb) { float f[8];
#pragma unroll
                    for (int e = 0; e < 8; ++e) { f[e] = __builtin_amdgcn_exp2f(sc[kb][e >> 2][e & 3] - mx); ls += f[e]; }
                    pf[kb] = __builtin_bit_cast(bf16x8, pack8(f)); }
                ls += __shfl_xor(ls, 16); ls += __shfl_xor(ls, 32);
                lrun = lrun * alpha + ls;
#pragma unroll
                for (int dt = 0; dt < 8; ++dt) { o[dt] = o[dt] * alpha;
#pragma unroll
                    for (int kb = 0; kb < 4; ++kb) o[dt] = __builtin_amdgcn_mfma_f32_16x16x32_bf16(*(const LAS bf16x8*)(lds + VOFF + (16 * dt + l15) * VP + (128 * half + 32 * kb + 8 * g4) * 2), pf[kb], o[dt], 0, 0, 0); }
            }
            const float il = 1.f / lrun;
            bf16* orow = OM + (size_t)(row0 + l15) * 512 + head * 128 + 4 * g4;
#pragma unroll
            for (int dt = 0; dt < 8; ++dt) { u32x2 w; w.x = pk2(o[dt][0] * il, o[dt][1] * il); w.y = pk2(o[dt][2] * il, o[dt][3] * il); *(GAS u32x2*)(orow + 16 * dt) = w; }
        }
    }
}

#define XB_TMO      128
#define XB_XCNT(j)  (256  + 64 * (j))
#define XB_XSUB(j)  (1280 + 64 * (j))
#define XB_XGEN(j)  (2304 + 64 * (j))
#define XB_TOP      3328
#define XB_TOPGEN   3392
#define XCD_BAR_WORDS 3456
#define XB_SPIN_CAP (1u << 22)
__device__ __forceinline__ unsigned xb_ld(unsigned* p)              { return __hip_atomic_load(p, __ATOMIC_RELAXED, __HIP_MEMORY_SCOPE_AGENT); }
__device__ __forceinline__ unsigned xb_add(unsigned* p, unsigned v) { return __hip_atomic_fetch_add(p, v, __ATOMIC_RELAXED, __HIP_MEMORY_SCOPE_AGENT); }
__device__ __forceinline__ unsigned xb_xcc_id() { return (unsigned)__builtin_amdgcn_s_getreg((3 << 11) | 20) & 0xFu; }
#define XB_SPIN(cond, bar) do { unsigned _sp = 0; while (cond) { __builtin_amdgcn_s_sleep(1); \
    if ((++_sp & 255u) == 0u) { if (xb_ld(&(bar)[XB_TMO])) break; if (_sp > XB_SPIN_CAP) { atomicAdd(&(bar)[XB_TMO], 1u); break; } } } } while (0)
struct XcdBarrier { unsigned* bar; unsigned x; volatile LAS unsigned* st; };
__device__ __forceinline__ XcdBarrier xcd_barrier_post(unsigned* bar, volatile LAS unsigned* st) {
    XcdBarrier b; b.bar = bar; b.x = xb_xcc_id(); b.st = st;
    if (threadIdx.x == 0) (void)xb_add(&bar[XB_XCNT(b.x)], 1u);
    return b;
}
__device__ __forceinline__ void xcd_barrier_complete(unsigned* bar, unsigned x, unsigned& nloc, unsigned& nx) {
    const unsigned G = gridDim.x * gridDim.y * gridDim.z;
    unsigned sum, cnt, mine, sp = 0u;
    for (;;) {
        sum = 0u; cnt = 0u; mine = 0u;
#pragma unroll
        for (unsigned j = 0; j < 16; ++j) { const unsigned c = xb_ld(&bar[XB_XCNT(j)]); sum += c; cnt += (c > 0u) ? 1u : 0u; mine = (j == x) ? c : mine; }
        if (sum == G) break;
        __builtin_amdgcn_s_sleep(1);
        if ((++sp & 255u) == 0u) { if (xb_ld(&bar[XB_TMO])) break; if (sp > XB_SPIN_CAP) { atomicAdd(&bar[XB_TMO], 1u); break; } }
    }
    nloc = mine > 0u ? mine : 1u; nx = cnt > 0u ? cnt : 1u;
}
__device__ __forceinline__ void xcd_barrier(const XcdBarrier& b) {
    asm volatile("s_waitcnt vmcnt(0)" ::: "memory");
    __syncthreads();
    if (threadIdx.x == 0) {
        unsigned* bar = b.bar;
        __builtin_amdgcn_s_waitcnt(0);
        unsigned nloc = b.st[0], nx = b.st[1];
        if (nloc == 0u) { xcd_barrier_complete(bar, b.x, nloc, nx); b.st[0] = nloc; b.st[1] = nx; }
        const unsigned old = xb_add(&bar[XB_XSUB(b.x)], 1u);
        const unsigned gen = old / nloc;
        if (old + 1u == (gen + 1u) * nloc) {
            __builtin_amdgcn_fence(__ATOMIC_RELEASE, "agent");
            asm volatile("s_waitcnt vmcnt(0)" ::: "memory");
            const unsigned og = xb_add(&bar[XB_TOP], 1u);
            const unsigned tg = og / nx;
            if (og + 1u == (tg + 1u) * nx) xb_add(&bar[XB_TOPGEN], 1u);
            else XB_SPIN(xb_ld(&bar[XB_TOPGEN]) == tg, bar);
            __builtin_amdgcn_fence(__ATOMIC_ACQUIRE, "agent");
            xb_add(&bar[XB_XGEN(b.x)], 1u);
            asm volatile("s_waitcnt vmcnt(0)" ::: "memory");
        } else {
            XB_SPIN(xb_ld(&bar[XB_XGEN(b.x)]) == gen, bar);
            __builtin_amdgcn_fence(__ATOMIC_ACQUIRE, "agent");
            asm volatile("s_waitcnt vmcnt(0)" ::: "memory");
        }
    }
    __syncthreads();
}

__device__ __forceinline__ void panel_barrier(unsigned* cnt, unsigned target, bool same_xcd) {
    asm volatile("s_waitcnt vmcnt(0)" ::: "memory");
    __syncthreads();
    if (threadIdx.x == 0) {
        if (!same_xcd) { __builtin_amdgcn_fence(__ATOMIC_RELEASE, "agent"); asm volatile("s_waitcnt vmcnt(0)" ::: "memory"); }
        __hip_atomic_fetch_add(cnt, 1u, __ATOMIC_RELAXED, __HIP_MEMORY_SCOPE_AGENT);
        unsigned sp = 0;
        while (__hip_atomic_load(cnt, __ATOMIC_RELAXED, __HIP_MEMORY_SCOPE_AGENT) < target) { __builtin_amdgcn_s_sleep(1); if (++sp > (1u << 24)) break; }
        __builtin_amdgcn_fence(__ATOMIC_ACQUIRE, "agent");
        asm volatile("s_waitcnt vmcnt(0)" ::: "memory");
    }
    __syncthreads();
}
__device__ __forceinline__ void panel_wait(unsigned* cnt, unsigned target) {
    if (threadIdx.x == 0) {
        unsigned sp = 0;
        while (__hip_atomic_load(cnt, __ATOMIC_RELAXED, __HIP_MEMORY_SCOPE_AGENT) < target) { __builtin_amdgcn_s_sleep(1); if (++sp > (1u << 24)) break; }
        __builtin_amdgcn_fence(__ATOMIC_ACQUIRE, "agent");
        asm volatile("s_waitcnt vmcnt(0)" ::: "memory");
    }
    __syncthreads();
}

__global__ void __launch_bounds__(NTHREADS, 2) mega(Params p) {
    extern __shared__ __attribute__((aligned(16))) unsigned char lds_raw[];
    LAS unsigned char* lds = (LAS unsigned char*)lds_raw;
    cg::grid_group grid = cg::this_grid();
    volatile LAS unsigned* st = (volatile LAS unsigned*)(lds + LDS_CTL + 256);
    if (threadIdx.x < 2) st[threadIdx.x] = 0u;
    __syncthreads();
    const XcdBarrier xb = xcd_barrier_post((unsigned*)p.ws, st);
    unsigned pgen = 0; bool same_xcd = false;
    { int pm0, pn0; pg8::pmpn(pg8::xcd_remap((int)blockIdx.x, 256), 64, 4, pm0, pn0);
      if (threadIdx.x == 0) __hip_atomic_store((unsigned*)(p.ws + 49152) + 4 * pm0 + pn0, xb.x + 1u, __ATOMIC_RELAXED, __HIP_MEMORY_SCOPE_AGENT); }
    constexpr int NSTEP = 2 + NCH * 2 * 9;
    for (int step = 0; step < NSTEP; ++step) {
        Params q = p; { unsigned char* wsq = p.ws; asm volatile("" : "+s"(wsq)); q.ws = wsq; }
        int bid = blockIdx.x; asm volatile("" : "+s"(bid));
        int pm, pn; pg8::pmpn(pg8::xcd_remap(bid, 256), 64, 4, pm, pn);
        int gt = -1; Ctx C{q.ws, 0, 0}; bool gb = true;
        const void* nx = nullptr; const float* ngpost = nullptr; const float* ngpre = nullptr; int ninst = 0, ndst32 = 0;
        if (step == 0) { init_phase(q, lds); }
        else if (step == 1) { gt = G_MEMKV; prenorm_rows(q, 0, pm, pn); }
        else {
            const int s2 = step - 2, c = s2 / 18, r = s2 - c * 18, l = r / 9, k = r - l * 9;
            C.l = l; C.c = c; gb = (k == 0 || k == 8);
            switch (k) {
            case 0: gt = G_WIN; break;
            case 1: poolconv_phase(q, l, pm, pn); dilattn_phase(q, lds, pm, pn); break;
            case 2: gt = G_CHAIN; break;
            case 3: gt = G_OUT; nx = q.ws + WS_X16; ngpost = q.norm_mix_post + l * 1024; ngpre = q.norm_mem_pre + l * 1024; ninst = (c * 2 + l) * 3 + 0; break;
            case 4: gt = G_MQ; break;
            case 5: memattn_phase(q, l, c, lds, pm, pn); break;
            case 6: gt = G_MO; nx = q.ws + WS_X16; ngpost = q.norm_mem_post + l * 1024; ngpre = q.norm_ffn_pre + l * 1024; ninst = (c * 2 + l) * 3 + 1; break;
            case 7: gt = G_UP; break;
            default: gt = G_DOWN; nx = q.ws + WS_X16; ndst32 = (l == 1); ngpost = q.norm_ffn_post + l * 1024; ngpre = l == 0 ? q.norm_mix_pre + 1024 : nullptr; ninst = (c * 2 + l) * 3 + 2;
                if (pm & 15) { panel_wait((unsigned*)(q.ws + WS_PCNT) + 64 * (pm - 1), 4u * pgen); ffnfix_local(q, l, pm); }
                break;
            }
        }
        if (gt >= 0) { Gen G{C, gt, pm, pn};
            if (gt == G_WIN) { Epi<1> E{C}; pg8::gemm_phase(lds, G, E); }
            else if (gt == G_CHAIN) { Epi<2> E{C}; pg8::gemm_phase(lds, G, E); }
            else if (gt == G_UP) { Epi<4> E{C, nullptr, nullptr, q.conv_ffn_w + (size_t)C.l * 3 * DFF, nullptr, nullptr, nullptr, lds + LDS_CTL + 1024, 0}; pg8::gemm_phase(lds, G, E); }
            else if (nx) { Epi<3> E{C, nx, ndst32 ? (void*)q.out : (void*)(q.ws + WS_X16), ngpost, ngpre, q.ws + WS_SSQ + 65536 + (size_t)ninst * SSQ_INST, (unsigned*)(q.ws + WS_SSQ) + ninst * 128, lds + LDS_CTL + 1024, ndst32}; pg8::gemm_phase(lds, G, E); }
            else { Epi<0> E{C}; pg8::gemm_phase(lds, G, E); } }
        if (step == 2 + 17) prenorm_rows(q, 1, pm, pn);
        if (step + 1 < NSTEP) {
            if (step == 0) { if (p.ph_lo == 0x5eed) grid.sync(); else xcd_barrier(xb);
                unsigned* xid = (unsigned*)(q.ws + 49152) + 4 * pm;
                const unsigned x0 = __hip_atomic_load(xid + 0, __ATOMIC_RELAXED, __HIP_MEMORY_SCOPE_AGENT), x1 = __hip_atomic_load(xid + 1, __ATOMIC_RELAXED, __HIP_MEMORY_SCOPE_AGENT),
                               x2 = __hip_atomic_load(xid + 2, __ATOMIC_RELAXED, __HIP_MEMORY_SCOPE_AGENT), x3 = __hip_atomic_load(xid + 3, __ATOMIC_RELAXED, __HIP_MEMORY_SCOPE_AGENT);
                same_xcd = __builtin_amdgcn_readfirstlane((int)((x0 == x1) && (x1 == x2) && (x2 == x3) && (x0 == xb.x + 1u))) != 0; }
            else if (gb) xcd_barrier(xb);
            else { ++pgen; const int kk = (step - 2) % 9; panel_barrier((unsigned*)(q.ws + WS_PCNT) + 64 * pm, 4u * pgen, same_xcd && kk != 7); }
        }
    }
}

extern "C" void kernel_launch(void* const* d_in, const int* in_sizes, int n_in, void* d_out, int out_size, void* d_ws, size_t ws_size, hipStream_t stream) {
    static int grid = 0;
    if (grid == 0) {
        if (n_in != 24 || ws_size < WS_END) { fprintf(stderr, "kernel_launch: unexpected n_in %d / ws_size %zu\n", n_in, ws_size); grid = -1; return; }
        int dev = 0, cus = 0, per_cu = 0;
        hipGetDevice(&dev); hipDeviceGetAttribute(&cus, hipDeviceAttributeMultiprocessorCount, dev);
        hipFuncSetAttribute((const void*)mega, hipFuncAttributeMaxDynamicSharedMemorySize, LDS_BYTES);
        hipOccupancyMaxActiveBlocksPerMultiprocessor(&per_cu, (const void*)mega, NTHREADS, LDS_BYTES);
        if (per_cu < 1) per_cu = 1;
        grid = cus * per_cu;
        if (grid != 256) { fprintf(stderr, "kernel_launch: this kernel needs exactly 256 co-resident workgroups (got %d)\n", grid); grid = -1; return; }
        (void)hipGetLastError();
    }
    if (grid < 0) return;
    (void)hipMemsetAsync(d_ws, 0, 65536, stream);
    (void)hipMemsetAsync((char*)d_ws + WS_SSQ, 0, 8192, stream);
    Params p{};
    p.x = (const float*)d_in[0]; p.mem = (const float*)d_in[1]; p.positions = (const int*)d_in[2];
    p.norm_mix_pre = (const float*)d_in[3]; p.norm_mix_post = (const float*)d_in[4]; p.w_in = (const float*)d_in[5]; p.pool_w = (const float*)d_in[6]; p.pool_scale = (const float*)d_in[7];
    p.conv_b_w = (const float*)d_in[8]; p.w_branch_a = (const float*)d_in[9]; p.w_branch_b = (const float*)d_in[10]; p.w_branch_c = (const float*)d_in[11]; p.w_out = (const float*)d_in[12];
    p.norm_mem_pre = (const float*)d_in[13]; p.norm_mem_post = (const float*)d_in[14]; p.norm_memkv = (const float*)d_in[15]; p.w_mq = (const float*)d_in[16]; p.w_mkv = (const float*)d_in[17]; p.w_mo = (const float*)d_in[18];
    p.norm_ffn_pre = (const float*)d_in[19]; p.norm_ffn_post = (const float*)d_in[20]; p.w_up = (const float*)d_in[21]; p.conv_ffn_w = (const float*)d_in[22]; p.w_down = (const float*)d_in[23];
    p.out = (float*)d_out; p.ws = (unsigned char*)d_ws;
#if 1
    p.ph_lo = 0; p.ph_hi = 0;
    void* args[] = {&p};
    hipError_t e = hipLaunchCooperativeKernel((const void*)mega, dim3(grid), dim3(NTHREADS), args, LDS_BYTES, stream);
    if (e != hipSuccess) fprintf(stderr, "cooperative launch failed: %s (grid %d)\n", hipGetErrorString(e), grid);
#else
    for (int s = 0; s < N_STEPS; ++s) { p.ph_lo = s; p.ph_hi = s + 1; hipLaunchKernelGGL(mega, dim3(grid), dim3(NTHREADS), LDS_BYTES, stream, p); }
#endif
}
```

```cpp
#include <hip/hip_runtime.h>
#include <hip/hip_cooperative_groups.h>
#include <cstdio>
#include <cstdint>
namespace cg = cooperative_groups;

#ifndef MK_ONE_LAUNCH
#define MK_ONE_LAUNCH 1
#endif

#ifndef PM
#define PM 63
#endif
#ifndef REP
#define REP 0
#endif
#define NREP(bit) ((REP & (bit)) ? 2 : 1)
#define LAS __attribute__((address_space(3)))
#define GAS
typedef unsigned short bf16;
typedef short bf16x8 __attribute__((ext_vector_type(8)));
typedef float f32x4 __attribute__((ext_vector_type(4)));
typedef unsigned u32x4 __attribute__((ext_vector_type(4)));
typedef unsigned u32x2 __attribute__((ext_vector_type(2)));

constexpr int NB = 8, S = 4096, D = 1024, TC = 16384, NCH = 2, BC = 4;
constexpr int INW = 6912, DFF = 2816;
constexpr float EPS = 1e-6f;
constexpr float LOG2E = 1.4426950408889634f;

constexpr size_t MiB = 1u << 20;
constexpr size_t LW = 19922944;
constexpr size_t OW_IN = 0, OW_CAT = 7077888, OW_OUT = OW_CAT + 1048576, OW_MQ = OW_OUT + 1048576, OW_MKV = OW_MQ + 524288,
                 OW_MO = OW_MKV + 1048576, OW_UP = OW_MO + 524288, OW_DOWN = OW_UP + 5767168;
static_assert(OW_DOWN + 2883584 == LW, "weights");
constexpr size_t WS_W = 1 * MiB, WS_CS = 78 * MiB, WS_MEMK = 80 * MiB, WS_MEMVT = 84 * MiB, WS_H = 88 * MiB;
constexpr size_t WS_R1 = 120 * MiB, WS_R2 = 336 * MiB, WS_Y = 432 * MiB, WS_END = 508 * MiB;
constexpr size_t WS_X16 = WS_Y;
constexpr size_t WS_UABC = WS_R1, WS_QP = WS_R1 + 48 * MiB, WS_KP = WS_R1 + 72 * MiB, WS_VT = WS_R1 + 96 * MiB, WS_G = WS_R1 + 120 * MiB;
constexpr size_t WS_HM = WS_R2;
constexpr size_t PSTRIDE = 1572864, PO_XCAT = 0, PO_MERGED = 524288, PO_QM = 1048576, PO_OM = 1310720, PO_Z = 0;
constexpr size_t WS_RAW = 496 * MiB, WS_SSQ = 501 * MiB, WS_PCNT = 32768;
constexpr size_t SSQ_INST = 2 * 16384 * 4 * 4;
static_assert(WS_W + 2 * LW * 2 <= WS_CS, "ws map");

constexpr int LDS_BYTES = 147456, LDS_CTL = 137216;
constexpr int NTHREADS = 512, NWAVES = 8;

struct Params {
    const float* x; const float* mem; const int* positions;
    const float* norm_mix_pre; const float* norm_mix_post; const float* w_in; const float* pool_w; const float* pool_scale;
    const float* conv_b_w; const float* w_branch_a; const float* w_branch_b; const float* w_branch_c; const float* w_out;
    const float* norm_mem_pre; const float* norm_mem_post; const float* norm_memkv; const float* w_mq; const float* w_mkv; const float* w_mo;
    const float* norm_ffn_pre; const float* norm_ffn_post; const float* w_up; const float* conv_ffn_w; const float* w_down;
    float* out; unsigned char* ws; int ph_lo, ph_hi;
};

__device__ __forceinline__ unsigned f2bf(float f) { unsigned u = __builtin_bit_cast(unsigned, f); return (u + 0x7fffu + ((u >> 16) & 1u)) >> 16; }
__device__ __forceinline__ unsigned pk2(float lo, float hi) { unsigned r; asm("v_cvt_pk_bf16_f32 %0, %1, %2" : "=v"(r) : "v"(lo), "v"(hi)); return r; }
__device__ __forceinline__ float bflo(unsigned u) { return __builtin_bit_cast(float, u << 16); }
__device__ __forceinline__ float bfhi(unsigned u) { return __builtin_bit_cast(float, u & 0xffff0000u); }
__device__ __forceinline__ int otid() { int t = threadIdx.x; asm volatile("" : "+v"(t)); return t; }
__device__ __forceinline__ float wave_sum(float v) {
#pragma unroll
    for (int o = 1; o < 64; o <<= 1) v += __shfl_xor(v, o);
    return v;
}
__device__ __forceinline__ void unpack8(const u32x4 w, float* f) {
    f[0] = bflo(w.x); f[1] = bfhi(w.x); f[2] = bflo(w.y); f[3] = bfhi(w.y); f[4] = bflo(w.z); f[5] = bfhi(w.z); f[6] = bflo(w.w); f[7] = bfhi(w.w);
}
__device__ __forceinline__ u32x4 pack8(const float* f) {
    u32x4 w; w.x = pk2(f[0], f[1]); w.y = pk2(f[2], f[3]); w.z = pk2(f[4], f[5]); w.w = pk2(f[6], f[7]); return w;
}

namespace pg8 {
constexpr int BM = 256, BK = 64, HALF = 128, HTB = HALF * BK * 2, NXCD = 8, WGM = 8;
__device__ __forceinline__ int lds_byte(int r, int c) { const int st = (r >> 4) * 2 + (c >> 5), rr = r & 15, cc = c & 31, ob = rr * 64 + cc * 2; return st * 1024 + (ob ^ (((ob >> 9) & 1) << 5)); }
__device__ __forceinline__ void stage_rc(int b, int& R, int& C) { const int st = b / 1024, sb = b % 1024, swz = sb ^ (((sb >> 9) & 1) << 5); R = (st >> 1) * 16 + swz / 64; C = (st & 1) * 32 + (swz % 64) / 2; }
__device__ __forceinline__ int perm32(int rho) { const int n = rho >> 4, i = rho & 15; return 8 * (i >> 2) + 4 * n + (i & 3); }

enum { K_BF16 = 0, K_F32, K_GATE, K_Q, K_K, K_VT, K_CH0, K_CH1, K_CH2 };
struct Unit {
    const char* A; const char* B;
    unsigned pa, pb;
    int nt, kind, pm, pn, aux;
    void* dst; int ldc; float scale;
};
__device__ __forceinline__ int xcd_remap(int L, int nwg) { const int q = nwg / NXCD, r = nwg % NXCD, xcd = L % NXCD, off = L / NXCD; return (xcd < r ? xcd * (q + 1) : r * (q + 1) + (xcd - r) * q) + off; }
__device__ __forceinline__ void pmpn(int w, int nM, int nN, int& pm, int& pn) { const int nig = WGM * nN, gid = w / nig, fm = gid * WGM, gsz = (nM - fm) < WGM ? (nM - fm) : WGM; pm = fm + ((w % nig) % gsz); pn = (w % nig) / gsz; }

template <class Gen, class Epi>
__device__ __forceinline__ void gemm_phase(LAS unsigned char* lds, const Gen& S, const Epi& E) {
    const int tid = otid(), wid = __builtin_amdgcn_readfirstlane(tid >> 6), lane = tid & 63, wr = wid >> 2, wc = wid & 3, fr = lane & 15, fq = lane >> 4;
    int R0, C0; stage_rc(tid * 16, R0, C0);
    const unsigned Rb0 = (unsigned)((R0 & ~31) + perm32(R0 & 31)), Ra0 = (unsigned)R0, c2 = (unsigned)C0 * 2u;
    const size_t kstep = (size_t)(BK * 2);
    const unsigned ldsw = (unsigned)wid * 1024u;
    const int aoff = lds_byte(wr * 64 + fr, fq * 8), boff = lds_byte(wc * 32 + fr, fq * 8);
#define PG8_SA(b, h) (((b) * 2 + (h)) * HTB)
#define PG8_SB(b, h) ((4 + (b) * 2 + (h)) * HTB)
#define PG8_STAGE(bufoff, gbase, R, pitch) do { const unsigned _v = (R) * (pitch) + c2; \
        __builtin_amdgcn_global_load_lds((const unsigned*)((const char*)(gbase) + _v), (LAS unsigned*)(lds + (bufoff) + ldsw), 16, 0, 0); \
        __builtin_amdgcn_global_load_lds((const unsigned*)((const char*)(gbase) + (_v + ((pitch) << 6))), (LAS unsigned*)(lds + (bufoff) + ldsw + 8192), 16, 0, 0); } while (0)
#define PG8_LDA(dst, b, h) do { _Pragma("unroll") for (int m = 0; m < 4; ++m) _Pragma("unroll") for (int k = 0; k < 2; ++k) dst[m][k] = *(const LAS bf16x8*)(lds + PG8_SA(b, h) + aoff + m * 2048 + k * 1024); } while (0)
#define PG8_LDB(dst, b, h) do { _Pragma("unroll") for (int n = 0; n < 2; ++n) _Pragma("unroll") for (int k = 0; k < 2; ++k) dst[n][k] = *(const LAS bf16x8*)(lds + PG8_SB(b, h) + boff + n * 2048 + k * 1024); } while (0)
#define PG8_MMA(ai, bj, At, Bt) do { __builtin_amdgcn_s_setprio(1); _Pragma("unroll") for (int m = 0; m < 4; ++m) _Pragma("unroll") for (int n = 0; n < 2; ++n) _Pragma("unroll") for (int k = 0; k < 2; ++k) \
        acc[ai][bj][m][n] = __builtin_amdgcn_mfma_f32_16x16x32_bf16(Bt[n][k], At[m][k], acc[ai][bj][m][n], 0, 0, 0); __builtin_amdgcn_s_setprio(0); } while (0)
#define PG8_WAIT_V(n) asm volatile("s_waitcnt vmcnt(" #n ")" ::: "memory")
#define PG8_WAIT_L(n) asm volatile("s_waitcnt lgkmcnt(" #n ")" ::: "memory")
#define PG8_BAR __builtin_amdgcn_s_barrier()
#define PG8_SCHED __builtin_amdgcn_sched_barrier(0)
    int ui = 0;
    const char* cA; const char* cB; unsigned pac, pbc; int nt;
    { Unit u0; if (!S.next(0, u0)) return; cA = u0.A; cB = u0.B; pac = u0.pa; pbc = u0.pb; nt = u0.nt; }
    f32x4 acc[2][2][4][2];
#pragma unroll
    for (int a = 0; a < 2; ++a)
#pragma unroll
        for (int b = 0; b < 2; ++b)
#pragma unroll
            for (int m = 0; m < 4; ++m)
#pragma unroll
                for (int n = 0; n < 2; ++n) acc[a][b][m][n] = (f32x4){0.f, 0.f, 0.f, 0.f};
    bf16x8 At[4][2], B0[2][2], B1[2][2];
    PG8_STAGE(PG8_SB(0, 0), cB, Rb0, pbc); PG8_STAGE(PG8_SB(0, 1), cB + (pbc << 7), Rb0, pbc); PG8_STAGE(PG8_SA(0, 0), cA, Ra0, pac); PG8_STAGE(PG8_SA(0, 1), cA + (pac << 7), Ra0, pac);
    if (wr == 1) PG8_BAR;
    PG8_WAIT_V(2); PG8_BAR;
    PG8_STAGE(PG8_SB(1, 0), cB + kstep, Rb0, pbc); PG8_STAGE(PG8_SA(1, 0), cA + kstep, Ra0, pac); PG8_STAGE(PG8_SB(1, 1), cB + (pbc << 7) + kstep, Rb0, pbc);
    PG8_WAIT_V(6); PG8_BAR;
    for (;;) {
        const char* nA = cA; const char* nB = cB; unsigned pan = pac, pbn = pbc; int ntn = nt; bool has_next;
        { Unit un; has_next = S.next(ui + 1, un); if (has_next) { nA = un.A; nB = un.B; pan = un.pa; pbn = un.pb; ntn = un.nt; } }
        for (int t = 0; t < nt; t += 2) {
            const bool last = (t == nt - 2);
            const char* a1 = cA + (size_t)(t + 1) * kstep;
            const char* a2 = last ? nA : cA + (size_t)(t + 2) * kstep; const char* b2 = last ? nB : cB + (size_t)(t + 2) * kstep;
            const char* a3 = a2 + kstep; const char* b3 = b2 + kstep;
            const unsigned pa2 = last ? pan : pac, pb2 = last ? pbn : pbc;
            PG8_LDB(B0, 0, 0); PG8_LDB(B1, 0, 1); PG8_SCHED; PG8_LDA(At, 0, 0); PG8_STAGE(PG8_SA(1, 1), a1 + (pac << 7), Ra0, pac);
            PG8_WAIT_V(8); PG8_WAIT_L(0); PG8_BAR; PG8_MMA(0, 0, At, B0); PG8_MMA(0, 1, At, B1); PG8_BAR; PG8_SCHED;
            PG8_LDA(At, 0, 1); PG8_STAGE(PG8_SB(0, 0), b2, Rb0, pb2); PG8_STAGE(PG8_SB(0, 1), b2 + (pb2 << 7), Rb0, pb2); PG8_STAGE(PG8_SA(0, 0), a2, Ra0, pa2);
            PG8_WAIT_V(8); PG8_WAIT_L(0); PG8_BAR; PG8_MMA(1, 0, At, B0); PG8_MMA(1, 1, At, B1); PG8_BAR; PG8_SCHED;
            PG8_LDB(B0, 1, 0); PG8_LDB(B1, 1, 1); PG8_SCHED; PG8_LDA(At, 1, 0); PG8_STAGE(PG8_SA(0, 1), a2 + (pa2 << 7), Ra0, pa2);
            PG8_WAIT_V(8); PG8_WAIT_L(0); PG8_BAR; PG8_MMA(0, 0, At, B0); PG8_MMA(0, 1, At, B1); PG8_BAR; PG8_SCHED;
            PG8_LDA(At, 1, 1); PG8_STAGE(PG8_SB(1, 0), b3, Rb0, pb2); PG8_STAGE(PG8_SB(1, 1), b3 + (pb2 << 7), Rb0, pb2); PG8_STAGE(PG8_SA(1, 0), a3, Ra0, pa2);
            PG8_WAIT_V(8); PG8_WAIT_L(0); PG8_BAR; PG8_MMA(1, 0, At, B0); PG8_MMA(1, 1, At, B1); PG8_BAR; PG8_SCHED;
        }
        if (wr == 0) PG8_BAR;
        bool reset;
        { Unit uc; S.next(ui, uc); int fre = fr, fqe = fq; asm volatile("" : "+v"(fre), "+v"(fqe));
          reset = E(acc, uc, wr, wc, fre, fqe); }
        if (!has_next) break;
        if (reset) {
#pragma unroll
            for (int a = 0; a < 2; ++a)
#pragma unroll
                for (int b = 0; b < 2; ++b)
#pragma unroll
                    for (int m = 0; m < 4; ++m)
#pragma unroll
                        for (int n = 0; n < 2; ++n) acc[a][b][m][n] = (f32x4){0.f, 0.f, 0.f, 0.f};
        }
        cA = nA; cB = nB; pac = pan; pbc = pbn; nt = ntn; ++ui;
        if (wr == 1) PG8_BAR;
    }
    PG8_WAIT_V(0);
    PG8_BAR;
#undef PG8_SA
#undef PG8_SB
#undef PG8_STAGE
#undef PG8_LDA
#undef PG8_LDB
#undef PG8_MMA
#undef PG8_WAIT_V
#undef PG8_WAIT_L
#undef PG8_BAR
#undef PG8_SCHED
}
}
using pg8::Unit;

struct Ctx {
    unsigned char* ws; int l, c;
    __device__ __forceinline__ bf16* W(size_t off) const { return (bf16*)(ws + WS_W) + (size_t)l * LW + off; }
    __device__ __forceinline__ bf16* buf(size_t off) const { return (bf16*)(ws + off); }
};

enum { G_MEMKV = 0, G_WIN, G_CHAIN, G_OUT, G_MQ, G_MO, G_UP, G_DOWN };

struct Gen {
    Ctx C; int type; int pm, pn;
    __device__ __forceinline__ bf16* pbuf(size_t off) const { return (bf16*)(C.ws + WS_R2 + (size_t)pm * PSTRIDE + off); }
    __device__ __forceinline__ bool punit(Unit& u, int ct, const bf16* A, unsigned pa, const bf16* B, unsigned pb, int nt, int kind, bf16* dst0, int ldc, float scale) const {
        u.A = (const char*)A; u.B = (const char*)B + (size_t)ct * 256 * pb; u.pa = pa; u.pb = pb; u.nt = nt; u.kind = kind; u.pm = pm; u.pn = ct; u.aux = 0;
        u.dst = dst0 ? (void*)(dst0 - (size_t)pm * 256 * ldc) : nullptr; u.ldc = ldc; u.scale = scale; return true;
    }
    __device__ __forceinline__ bool next(int i, Unit& u) const {
        const int G = gridDim.x, cb = blockIdx.x;
        const bf16* Hp = C.buf(WS_H) + (size_t)pm * 256 * 1024;
        switch (type) {
        case G_MEMKV: {
            const long L = (long)i * G + cb; if (L >= 64) return false;
            const int w = (int)L, seg = w >> 4, ll = seg >> 1, isv = seg & 1, j = w & 15;
            const bf16* Wkv = (const bf16*)(C.ws + WS_W) + (size_t)ll * LW + OW_MKV; const bf16* Hm = C.buf(WS_HM) + (size_t)ll * 2048 * 1024;
            u.pa = 2048; u.pb = 2048; u.nt = 16; u.kind = pg8::K_BF16; u.aux = 0; u.scale = 1.f;
            if (!isv) { u.pm = j >> 1; u.pn = j & 1; u.A = (const char*)(Hm + (size_t)u.pm * 256 * 1024); u.B = (const char*)(Wkv + (size_t)u.pn * 256 * 1024); u.dst = C.buf(WS_MEMK) + (size_t)ll * 2048 * 512; u.ldc = 512; }
            else { u.pm = j >> 3; u.pn = j & 7; u.A = (const char*)(Wkv + (size_t)(512 + u.pm * 256) * 1024); u.B = (const char*)(Hm + (size_t)u.pn * 256 * 1024); u.dst = C.buf(WS_MEMVT) + (size_t)ll * 512 * 2048; u.ldc = 2048; }
            return true; }
        case G_WIN: {
            const bool first = (C.c == 0 && C.l == 0);
            const int total = 64 * 24 + 192 + (first ? 64 : 0); const long L = (long)i * G + cb; if (L >= total) return false;
            int w = pg8::xcd_remap((int)L, total);
            if (w >= 1728) { w -= 1728; const int seg = w >> 4, ll = seg >> 1, isv = seg & 1, j = w & 15;
                const bf16* Wkv = (const bf16*)(C.ws + WS_W) + (size_t)ll * LW + OW_MKV; const bf16* Hm = C.buf(WS_HM) + (size_t)ll * 2048 * 1024;
                u.pa = 2048; u.pb = 2048; u.nt = 16; u.kind = pg8::K_BF16; u.aux = 0; u.scale = 1.f;
                if (!isv) { u.pm = j >> 1; u.pn = j & 1; u.A = (const char*)(Hm + (size_t)u.pm * 256 * 1024); u.B = (const char*)(Wkv + (size_t)u.pn * 256 * 1024); u.dst = C.buf(WS_MEMK) + (size_t)ll * 2048 * 512; u.ldc = 512; }
                else { u.pm = j >> 3; u.pn = j & 7; u.A = (const char*)(Wkv + (size_t)(512 + u.pm * 256) * 1024); u.B = (const char*)(Hm + (size_t)u.pn * 256 * 1024); u.dst = C.buf(WS_MEMVT) + (size_t)ll * 512 * 2048; u.ldc = 2048; }
                return true; }
            const bf16* H = C.buf(WS_H); const bf16* Win = C.W(OW_IN);
            u.pa = 2048; u.nt = 16; u.scale = 1.f; u.dst = nullptr; u.ldc = 0;
            if (w < 1536) { int tm, tn; pg8::pmpn(w, 64, 24, tm, tn); const int tile = tn < 12 ? tn : tn + 3;
                u.A = (const char*)(H + (size_t)tm * 256 * 1024); u.B = (const char*)(Win + (size_t)tile * 256 * 1024); u.pb = 2048; u.pm = tm;
                if (tile < 6) { u.kind = pg8::K_BF16; u.pn = tile; u.dst = C.buf(WS_UABC); u.ldc = 1536; u.aux = 0; }
                else if (tile < 9) { u.kind = pg8::K_Q; u.pn = tile - 6; u.aux = tile - 6; }
                else if (tile < 12) { u.kind = pg8::K_K; u.pn = tile - 9; u.aux = tile - 9; }
                else { u.kind = pg8::K_GATE; u.pn = tile - 15; u.dst = C.buf(WS_G); u.ldc = 3072; u.aux = 0; }
            } else { w -= 1536; const int g = w >> 6, tn = w & 63, bl = tn >> 4, p0 = 256 * (tn & 15), sh = 2 * g, Ld = S >> sh, r = p0 / Ld, i0 = p0 % Ld, s0 = r + (i0 << sh);
                u.A = (const char*)(Win + (size_t)(3072 + 256 * g) * 1024); u.B = (const char*)(H + (size_t)(bl * S + s0) * 1024); u.pb = 2048u << sh;
                u.kind = pg8::K_VT; u.pm = g; u.pn = tn; u.aux = g; }
            return true; }
        case G_CHAIN: { if (i >= 3) return false;
            const int koff = i * 384;
            punit(u, pn, pbuf(PO_XCAT) + koff, 2048, C.W(OW_CAT) + koff, 2048, i < 2 ? 6 : 4, pg8::K_CH0 + i, pbuf(PO_MERGED), 1024, 1.f); u.aux = i; return true; }
        case G_OUT: return i == 0 && punit(u, pn, pbuf(PO_MERGED), 2048, C.W(OW_OUT), 2048, 16, pg8::K_F32, nullptr, 1024, 1.f);
        case G_MQ: return i == 0 && pn < 2 && punit(u, pn, Hp, 2048, C.W(OW_MQ), 2048, 16, pg8::K_BF16, pbuf(PO_QM), 512, 0.08838834764831845f * LOG2E);
        case G_MO: return i == 0 && punit(u, pn, pbuf(PO_OM), 1024, C.W(OW_MO), 1024, 8, pg8::K_F32, nullptr, 1024, 1.f);
        case G_UP: { const int ct = pn + 4 * i; return ct < 22 && punit(u, ct, Hp, 2048, C.W(OW_UP), 2048, 16, pg8::K_BF16, pbuf(PO_Z), DFF, 1.f); }
        default: return i == 0 && punit(u, pn, pbuf(PO_Z), 5632, C.W(OW_DOWN), 5632, 44, pg8::K_F32, nullptr, 1024, 1.f);
        }
    }
};

__device__ __forceinline__ void panel_exchange(unsigned* cnt) {
    asm volatile("s_waitcnt vmcnt(0)" ::: "memory");
    __syncthreads();
    if (threadIdx.x == 0) {
        __hip_atomic_fetch_add(cnt, 1u, __ATOMIC_RELAXED, __HIP_MEMORY_SCOPE_AGENT);
        unsigned sp = 0;
        while (__hip_atomic_load(cnt, __ATOMIC_RELAXED, __HIP_MEMORY_SCOPE_AGENT) < 4u) { __builtin_amdgcn_s_sleep(1); if (++sp > (1u << 24)) break; }
    }
    __syncthreads();
}
template <int MODE> struct Epi {
    Ctx C;
    const void* xsrc; void* xout; const float* gpost; const float* gpre; unsigned char* inst; unsigned* cnts; LAS unsigned char* ldsx; int dstf32;
    __device__ __forceinline__ bool operator()(f32x4 (&acc)[2][2][4][2], const Unit& u, int wr, int wc, int fr, int fq) const {
        const int rl0 = wr * 64 + fr, cl0 = wc * 32 + 8 * fq;
        if (MODE == 4) {
            LAS float* Hl = (LAS float*)ldsx;
            const float* cw = gpost; bf16* Z = (bf16*)u.dst;
            float* RAWL = (float*)(C.ws + WS_RAW); float* RAWF = RAWL + 64 * 2 * DFF;
            const int clane = wc * 32 + 8 * fq, lane = fq * 16 + fr;
#pragma unroll
            for (int ai = 0; ai < 2; ++ai) if (fr >= 14) { LAS float* d = Hl + ((ai * 2 + wr) * 2 + (fr - 14)) * 128 + clane; *(LAS f32x4*)d = acc[ai][0][3][0]; *(LAS f32x4*)(d + 4) = acc[ai][0][3][1]; }
            if (wr == 1 && fr >= 14) { float* d = RAWL + ((size_t)u.pm * 2 + (fr - 14)) * DFF + u.pn * 128 + clane; *(f32x4*)d = acc[1][0][3][0]; *(GAS f32x4*)(d + 4) = acc[1][0][3][1]; }
            if (wr == 0 && fr < 2) { float* d = RAWF + ((size_t)u.pm * 2 + fr) * (2 * DFF) + u.pn * 128 + clane;
                *(f32x4*)d = acc[0][0][0][0]; *(GAS f32x4*)(d + 4) = acc[0][0][0][1]; *(GAS f32x4*)(d + DFF) = acc[0][1][0][0]; *(GAS f32x4*)(d + DFF + 4) = acc[0][1][0][1]; }
            asm volatile("s_waitcnt lgkmcnt(0)" ::: "memory"); __syncthreads();
            f32x4 w[3][2];
#pragma unroll
            for (int j = 0; j < 3; ++j)
#pragma unroll
                for (int n = 0; n < 2; ++n) w[j][n] = *(const GAS f32x4*)(cw + j * DFF + u.pn * 128 + clane + 4 * n);
            const int src1 = (lane & 48) | ((lane - 1) & 15), src2 = (lane & 48) | ((lane - 2) & 15);
#pragma unroll
            for (int ai = 0; ai < 2; ++ai) {
                const int strip = ai * 2 + wr;
                f32x4 p1[2], p2[2];
#pragma unroll
                for (int n = 0; n < 2; ++n) { p1[n] = (f32x4){0.f, 0.f, 0.f, 0.f}; p2[n] = p1[n];
                    if (strip > 0) { const LAS float* hs = Hl + ((strip - 1) * 2) * 128 + clane + 4 * n; p2[n] = *(const LAS f32x4*)hs; p1[n] = *(const LAS f32x4*)(hs + 128); } }
#pragma unroll
                for (int m = 0; m < 4; ++m) {
                    bf16* zp = Z + (size_t)(u.pm * 256 + ai * 128 + m * 16 + rl0) * DFF + u.pn * 128 + clane;
                    float o[8];
#pragma unroll
                    for (int n = 0; n < 2; ++n) {
                        const f32x4 cur = acc[ai][0][m][n], ub = acc[ai][1][m][n]; f32x4 r1, r2;
#pragma unroll
                        for (int e = 0; e < 4; ++e) { r1[e] = __shfl(cur[e], src1); r2[e] = __shfl(cur[e], src2); }
                        const f32x4 pv1 = (fr >= 1) ? r1 : p1[n], pv2 = (fr >= 2) ? r2 : (fr == 1 ? p1[n] : p2[n]);
                        const f32x4 a = w[0][n] * pv2 + w[1][n] * pv1 + w[2][n] * cur;
#pragma unroll
                        for (int e = 0; e < 4; ++e) o[4 * n + e] = a[e] * __builtin_amdgcn_rcpf(1.f + __builtin_amdgcn_exp2f(-LOG2E * a[e])) * ub[e];
                        p1[n] = (fr == 0) ? r1 : r2; p2[n] = r2;
                    }
                    *(u32x4*)zp = pack8(o);
                }
            }
            return true;
        }
        if (MODE == 3) {
            float* slot1 = (float*)inst; float* slot2 = slot1 + 16384 * 4; unsigned* cnt1 = cnts; unsigned* cnt2 = cnts + 64;
            LAS float* P = (LAS float*)(ldsx); LAS float* Sx = P + 1024;
            const int row0 = u.pm * 256 + rl0, col0 = u.pn * 256 + cl0, tid = (wr * 4 + wc) * 64 + fq * 16 + fr;
            bf16* H = C.buf(WS_H);
#pragma unroll
            for (int ai = 0; ai < 2; ++ai)
#pragma unroll
                for (int m = 0; m < 4; ++m) { float sq = 0.f;
#pragma unroll
                    for (int bj = 0; bj < 2; ++bj)
#pragma unroll
                        for (int n = 0; n < 2; ++n) { const f32x4 v = acc[ai][bj][m][n]; sq += v[0] * v[0] + v[1] * v[1] + v[2] * v[2] + v[3] * v[3]; }
                    sq += __shfl_xor(sq, 16); sq += __shfl_xor(sq, 32);
                    if (fq == 0) P[(ai * 128 + m * 16 + rl0) * 4 + wc] = sq; }
            asm volatile("s_waitcnt lgkmcnt(0)" ::: "memory"); __syncthreads();
            if (tid < 256) { const float tot = (P[tid * 4 + 0] + P[tid * 4 + 1]) + (P[tid * 4 + 2] + P[tid * 4 + 3]);
                __hip_atomic_store(slot1 + (size_t)(u.pm * 256 + tid) * 4 + u.pn, tot, __ATOMIC_RELAXED, __HIP_MEMORY_SCOPE_AGENT); }
            const size_t gbase = ((size_t)C.c * TC + u.pm * 256 + rl0) * 1024 + col0;
            const bf16* xs = (const bf16*)xsrc;
            f32x4 gpv[2][2];
#pragma unroll
            for (int bj = 0; bj < 2; ++bj) { gpv[bj][0] = *(const GAS f32x4*)(gpost + col0 + bj * 128); gpv[bj][1] = *(const GAS f32x4*)(gpost + col0 + bj * 128 + 4); }
            u32x4 pre[4][2];
#pragma unroll
            for (int m = 0; m < 4; ++m)
#pragma unroll
                for (int bj = 0; bj < 2; ++bj) pre[m][bj] = *(const GAS u32x4*)(xs + gbase + (size_t)(m * 16) * 1024 + bj * 128);
            panel_exchange(cnt1 + u.pm);
            if (tid < 256) { const float* sl = slot1 + (size_t)(u.pm * 256 + tid) * 4;
                const float a0 = __hip_atomic_load(sl + 0, __ATOMIC_RELAXED, __HIP_MEMORY_SCOPE_AGENT), a1 = __hip_atomic_load(sl + 1, __ATOMIC_RELAXED, __HIP_MEMORY_SCOPE_AGENT),
                            a2 = __hip_atomic_load(sl + 2, __ATOMIC_RELAXED, __HIP_MEMORY_SCOPE_AGENT), a3 = __hip_atomic_load(sl + 3, __ATOMIC_RELAXED, __HIP_MEMORY_SCOPE_AGENT);
                Sx[tid] = 1.f / sqrtf(((a0 + a1) + (a2 + a3)) * (1.f / 1024.f) + EPS); }
            asm volatile("s_waitcnt lgkmcnt(0)" ::: "memory"); __syncthreads();
#pragma unroll
            for (int ai = 0; ai < 2; ++ai)
#pragma unroll
                for (int m = 0; m < 4; ++m) { const int rl = ai * 128 + m * 16 + rl0;
                    const float rs = Sx[rl];
                    const size_t go = gbase + (size_t)(ai * 128 + m * 16) * 1024; float sq = 0.f;
#pragma unroll
                    for (int bj = 0; bj < 2; ++bj) {
                        const f32x4 gp0 = gpv[bj][0], gp1 = gpv[bj][1]; const u32x4 xw = pre[m][bj];
                        const f32x4 xv0 = {bflo(xw.x), bfhi(xw.x), bflo(xw.y), bfhi(xw.y)}, xv1 = {bflo(xw.z), bfhi(xw.z), bflo(xw.w), bfhi(xw.w)};
                        if (ai == 0) pre[m][bj] = *(const GAS u32x4*)(xs + go + (size_t)128 * 1024 + bj * 128);
                        const f32x4 v0 = xv0 + acc[ai][bj][m][0] * rs * gp0, v1 = xv1 + acc[ai][bj][m][1] * rs * gp1;
                        if (dstf32) { *(GAS f32x4*)((float*)xout + go + bj * 128) = v0; *(GAS f32x4*)((float*)xout + go + bj * 128 + 4) = v1; }
                        else { u32x4 w; w.x = pk2(v0[0], v0[1]); w.y = pk2(v0[2], v0[3]); w.z = pk2(v1[0], v1[1]); w.w = pk2(v1[2], v1[3]); *(GAS u32x4*)((bf16*)xout + go + bj * 128) = w; }
                        acc[ai][bj][m][0] = v0; acc[ai][bj][m][1] = v1;
                        sq += v0[0] * v0[0] + v0[1] * v0[1] + v0[2] * v0[2] + v0[3] * v0[3] + v1[0] * v1[0] + v1[1] * v1[1] + v1[2] * v1[2] + v1[3] * v1[3]; }
                    if (gpre) { sq += __shfl_xor(sq, 16); sq += __shfl_xor(sq, 32); if (fq == 0) P[rl * 4 + wc] = sq; } }
            if (gpre) {
                asm volatile("s_waitcnt lgkmcnt(0)" ::: "memory"); __syncthreads();
                if (tid < 256) { const float tot = (P[tid * 4 + 0] + P[tid * 4 + 1]) + (P[tid * 4 + 2] + P[tid * 4 + 3]);
                    __hip_atomic_store(slot2 + (size_t)(u.pm * 256 + tid) * 4 + u.pn, tot, __ATOMIC_RELAXED, __HIP_MEMORY_SCOPE_AGENT); }
                f32x4 gqv[2][2];
#pragma unroll
                for (int bj = 0; bj < 2; ++bj) { gqv[bj][0] = *(const GAS f32x4*)(gpre + col0 + bj * 128); gqv[bj][1] = *(const GAS f32x4*)(gpre + col0 + bj * 128 + 4); }
                panel_exchange(cnt2 + u.pm);
                if (tid < 256) { const float* sl = slot2 + (size_t)(u.pm * 256 + tid) * 4;
                    const float a0 = __hip_atomic_load(sl + 0, __ATOMIC_RELAXED, __HIP_MEMORY_SCOPE_AGENT), a1 = __hip_atomic_load(sl + 1, __ATOMIC_RELAXED, __HIP_MEMORY_SCOPE_AGENT),
                                a2 = __hip_atomic_load(sl + 2, __ATOMIC_RELAXED, __HIP_MEMORY_SCOPE_AGENT), a3 = __hip_atomic_load(sl + 3, __ATOMIC_RELAXED, __HIP_MEMORY_SCOPE_AGENT);
                    Sx[tid] = 1.f / sqrtf(((a0 + a1) + (a2 + a3)) * (1.f / 1024.f) + EPS); }
                asm volatile("s_waitcnt lgkmcnt(0)" ::: "memory"); __syncthreads();
#pragma unroll
                for (int ai = 0; ai < 2; ++ai)
#pragma unroll
                    for (int m = 0; m < 4; ++m) { const int rl = ai * 128 + m * 16 + rl0, r = u.pm * 256 + rl;
                        const float rs = Sx[rl];
#pragma unroll
                        for (int bj = 0; bj < 2; ++bj) { const f32x4 g0 = gqv[bj][0], g1 = gqv[bj][1];
                            const f32x4 v0 = acc[ai][bj][m][0] * rs * g0, v1 = acc[ai][bj][m][1] * rs * g1;
                            u32x4 w; w.x = pk2(v0[0], v0[1]); w.y = pk2(v0[2], v0[3]); w.z = pk2(v1[0], v1[1]); w.w = pk2(v1[2], v1[3]);
                            *(GAS u32x4*)(H + (size_t)r * 1024 + col0 + bj * 128) = w; } }
            }
            return true;
        }
        int kind = u.kind;
        if (MODE == 0 && kind != pg8::K_F32) kind = pg8::K_BF16;
        if (MODE == 2) kind = pg8::K_CH0;
        if (MODE == 1 && (kind == pg8::K_F32 || kind > pg8::K_VT)) kind = pg8::K_BF16;
        switch (kind) {
        case pg8::K_BF16: {
            bf16* base = (bf16*)u.dst + (size_t)(u.pm * 256 + rl0) * u.ldc + u.pn * 256 + cl0; const float sc = u.scale;
#pragma unroll
            for (int ai = 0; ai < 2; ++ai)
#pragma unroll
                for (int m = 0; m < 4; ++m) { bf16* rowp = base + (size_t)(ai * 128 + m * 16) * u.ldc;
#pragma unroll
                    for (int bj = 0; bj < 2; ++bj) { const f32x4 v0 = acc[ai][bj][m][0] * sc, v1 = acc[ai][bj][m][1] * sc;
                        u32x4 w; w.x = pk2(v0[0], v0[1]); w.y = pk2(v0[2], v0[3]); w.z = pk2(v1[0], v1[1]); w.w = pk2(v1[2], v1[3]);
                        *(GAS u32x4*)(rowp + bj * 128) = w; } }
            return true; }
        case pg8::K_F32: { if (MODE != 0) return true;
            float* base = (float*)u.dst + (size_t)(u.pm * 256 + rl0) * u.ldc + u.pn * 256 + cl0;
#pragma unroll
            for (int ai = 0; ai < 2; ++ai)
#pragma unroll
                for (int m = 0; m < 4; ++m) { float* rowp = base + (size_t)(ai * 128 + m * 16) * u.ldc;
#pragma unroll
                    for (int bj = 0; bj < 2; ++bj) { *(GAS f32x4*)(rowp + bj * 128) = acc[ai][bj][m][0]; *(GAS f32x4*)(rowp + bj * 128 + 4) = acc[ai][bj][m][1]; } }
            return true; }
        case pg8::K_GATE: { if (MODE != 1) return true;
            bf16* base = (bf16*)u.dst + ((size_t)(u.pm * 12 + u.pn) * 16 * 8 + (wr * 4 + wc)) * 512 + (fq * 16 + fr) * 8;
#pragma unroll
            for (int ai = 0; ai < 2; ++ai)
#pragma unroll
                for (int m = 0; m < 4; ++m)
#pragma unroll
                    for (int bj = 0; bj < 2; ++bj) { float f[8];
#pragma unroll
                        for (int e = 0; e < 8; ++e) { const float v = acc[ai][bj][m][e >> 2][e & 3]; f[e] = fmaxf(__builtin_amdgcn_rcpf(1.f + __builtin_amdgcn_exp2f(-LOG2E * v)), 1e-20f); }
                        *(GAS u32x4*)(base + (size_t)((ai * 4 + m) * 2 + bj) * 8 * 512) = pack8(f); }
            return true; }
        case pg8::K_Q: case pg8::K_K: { if (MODE != 1) return true;
            const int g = u.aux, sh = 2 * g, Ld = S >> sh;
            bf16* dstb = C.buf(u.kind == pg8::K_Q ? WS_QP : WS_KP);
            const float* cs = (const float*)(C.ws + WS_CS);
            const float sc = (u.kind == pg8::K_Q) ? 0.125f * LOG2E : 1.f;
            const bool rot = ((wc & 1) == 0);
#pragma unroll
            for (int ai = 0; ai < 2; ++ai)
#pragma unroll
                for (int m = 0; m < 4; ++m) {
                    const int rloc = u.pm * 256 + ai * 128 + m * 16 + rl0;
                    const int bl = rloc >> 12, s = rloc & 4095, pos = (s & ((1 << sh) - 1)) * Ld + (s >> sh);
                    const float* csr = cs + (size_t)(C.c * TC + rloc) * 16;
                    f32x4 c0 = {1.f, 1.f, 1.f, 1.f}, c1 = c0, s0 = {0.f, 0.f, 0.f, 0.f}, s1 = s0;
                    if (rot) { const float* csq = csr + ((fq & 1) ? 0 : 0);
                        const f32x4 t0 = *(const GAS f32x4*)(csq), t1 = *(const GAS f32x4*)(csq + 4), t2 = *(const GAS f32x4*)(csq + 8), t3 = *(const GAS f32x4*)(csq + 12);
                        const bool act = fq < 2; const float sg = act ? ((fq == 0) ? -1.f : 1.f) : 0.f;
#pragma unroll
                        for (int e = 0; e < 4; ++e) { c0[e] = act ? t0[e] : 1.f; c1[e] = act ? t1[e] : 1.f; s0[e] = t2[e] * sg; s1[e] = t3[e] * sg; } }
#pragma unroll
                    for (int bj = 0; bj < 2; ++bj) {
                        f32x4 v0 = acc[ai][bj][m][0], v1 = acc[ai][bj][m][1];
                        if (rot) {
                            f32x4 o0, o1;
#pragma unroll
                            for (int e = 0; e < 4; ++e) { o0[e] = __shfl_xor(v0[e], 16); o1[e] = __shfl_xor(v1[e], 16); }
                            v0 = v0 * c0 + o0 * s0; v1 = v1 * c1 + o1 * s1;
                        }
                        v0 = v0 * sc; v1 = v1 * sc;
                        const int head = 4 * g + 2 * bj + (wc >> 1), dim = 32 * (wc & 1) + 8 * fq;
                        u32x4 w; w.x = pk2(v0[0], v0[1]); w.y = pk2(v0[2], v0[3]); w.z = pk2(v1[0], v1[1]); w.w = pk2(v1[2], v1[3]);
                        *(GAS u32x4*)(dstb + ((size_t)(bl * 12 + head) * S + pos) * 64 + dim) = w;
                    }
                }
            return true; }
        case pg8::K_VT: { if (MODE != 1) return true;
            const int g = u.aux, bl = u.pn >> 4, p0 = 256 * (u.pn & 15);
            bf16* dstb = C.buf(WS_VT);
#pragma unroll
            for (int ai = 0; ai < 2; ++ai)
#pragma unroll
                for (int m = 0; m < 4; ++m) { const int r = ai * 128 + m * 16 + rl0;
                    bf16* rowp = dstb + ((size_t)(bl * 12 + 4 * g + (r >> 6)) * 128 + ((p0 + cl0) >> 5)) * 2048 + (r & 63) * 32 + ((p0 + cl0) & 31);
#pragma unroll
                    for (int bj = 0; bj < 2; ++bj) { const f32x4 v0 = acc[ai][bj][m][0], v1 = acc[ai][bj][m][1];
                        u32x4 w; w.x = pk2(v0[0], v0[1]); w.y = pk2(v0[2], v0[3]); w.z = pk2(v1[0], v1[1]); w.w = pk2(v1[2], v1[3]);
                        *(GAS u32x4*)(rowp + bj * 4 * 2048) = w; } }
            return true; }
        default: { if (MODE != 2) return true;
            const int sub = u.aux;
            const bf16* gb = C.buf(WS_G) + ((size_t)(u.pm * 12 + 4 * sub + u.pn) * 16 * 8 + (wr * 4 + wc)) * 512 + (fq * 16 + fr) * 8;
            constexpr size_t GT = (size_t)4 * 16 * 8 * 512;
            bf16* ob = (bf16*)u.dst + (size_t)(u.pm * 256 + rl0) * 1024 + u.pn * 256 + cl0;
#pragma unroll
            for (int ai = 0; ai < 2; ++ai) {
                u32x4 gav[4][2], gnv[4][2];
#pragma unroll
                for (int m = 0; m < 4; ++m)
#pragma unroll
                    for (int bj = 0; bj < 2; ++bj) { const size_t co = (size_t)((ai * 4 + m) * 2 + bj) * 8 * 512;
                        gav[m][bj] = *(const GAS u32x4*)(gb + co); if (sub < 2) gnv[m][bj] = *(const GAS u32x4*)(gb + co + GT); }
#pragma unroll
                for (int m = 0; m < 4; ++m) { const size_t ro = (size_t)(ai * 128 + m * 16);
#pragma unroll
                    for (int bj = 0; bj < 2; ++bj) {
                        float ga[8]; unpack8(gav[m][bj], ga);
                        if (sub < 2) { float gn[8]; unpack8(gnv[m][bj], gn);
#pragma unroll
                            for (int e = 0; e < 8; ++e) acc[ai][bj][m][e >> 2][e & 3] *= ga[e] * __builtin_amdgcn_rcpf(gn[e]);
                        } else { float f[8];
#pragma unroll
                            for (int e = 0; e < 8; ++e) f[e] = acc[ai][bj][m][e >> 2][e & 3] * ga[e];
                            *(GAS u32x4*)(ob + ro * 1024 + bj * 128) = pack8(f); }
                    } }
            }
            return sub == 2; }
        }
    }
};

__device__ __forceinline__ void transpose_item(const float* W, int N, bf16* WT, int ldk, int koff, LAS float* scr, int item, int lane, bool upmap = false) {
    const int nblk = N / 32, kb = item / nblk, nb = item % nblk, k0 = 64 * kb, n0 = 32 * nb;
    const int r0 = !upmap ? n0 : (n0 < DFF ? (n0 >> 7) * 256 + (n0 & 127) : ((n0 - DFF) >> 7) * 256 + 128 + ((n0 - DFF) & 127));
#pragma unroll 8
    for (int i = 0; i < 32; ++i) { const int kk = 2 * i + (lane >> 5); scr[kk * 33 + (lane & 31)] = W[(size_t)(k0 + kk) * N + n0 + (lane & 31)]; }
    asm volatile("s_waitcnt lgkmcnt(0)" ::: "memory");
    const int c = lane & 7;
#pragma unroll
    for (int j = 0; j < 4; ++j) { const int n = (lane >> 3) + 8 * j; const LAS float* s = scr + (8 * c) * 33 + n;
        u32x4 o; o.x = pk2(s[0 * 33], s[1 * 33]); o.y = pk2(s[2 * 33], s[3 * 33]); o.z = pk2(s[4 * 33], s[5 * 33]); o.w = pk2(s[6 * 33], s[7 * 33]);
        *(GAS u32x4*)(WT + (size_t)(r0 + n) * ldk + koff + k0 + 8 * c) = o; }
    asm volatile("s_waitcnt lgkmcnt(0)" ::: "memory");
}

__device__ __forceinline__ void init_phase(const Params& p, LAS unsigned char* lds) {
    const int tid = otid(), lane = tid & 63, wave = tid >> 6;
    const int gw = blockIdx.x * NWAVES + wave, NGW = gridDim.x * NWAVES;
    const int gt = blockIdx.x * NTHREADS + tid, NGT = gridDim.x * NTHREADS;
    LAS float* scr = (LAS float*)(lds + wave * 16384);
    constexpr int I_IN = 16 * 216, I_B = 6 * 32, I_C = 4 * 32, I_OUT = 16 * 32, I_MQ = 16 * 16, I_MKV = 16 * 32, I_MO = 8 * 32, I_UP = 16 * 176, I_DN = 44 * 32;
    constexpr int I_LAYER = I_IN + I_B + I_C + I_OUT + I_MQ + I_MKV + I_MO + I_UP + I_DN;
    for (int it = gw; it < 2 * I_LAYER; it += NGW) {
        const int l = it / I_LAYER; int r = it - l * I_LAYER;
        bf16* Wl = (bf16*)(p.ws + WS_W) + (size_t)l * LW;
        if (r < I_IN) { transpose_item(p.w_in + (size_t)l * 1024 * INW, INW, Wl + OW_IN, 1024, 0, scr, r, lane); continue; } r -= I_IN;
        if (r < I_B) { transpose_item(p.w_branch_b + (size_t)l * 384 * 1024, 1024, Wl + OW_CAT, 1024, 384, scr, r, lane); continue; } r -= I_B;
        if (r < I_C) { transpose_item(p.w_branch_c + (size_t)l * 256 * 1024, 1024, Wl + OW_CAT, 1024, 768, scr, r, lane); continue; } r -= I_C;
        if (r < I_OUT) { transpose_item(p.w_out + (size_t)l * 1024 * 1024, 1024, Wl + OW_OUT, 1024, 0, scr, r, lane); continue; } r -= I_OUT;
        if (r < I_MQ) { transpose_item(p.w_mq + (size_t)l * 1024 * 512, 512, Wl + OW_MQ, 1024, 0, scr, r, lane); continue; } r -= I_MQ;
        if (r < I_MKV) { transpose_item(p.w_mkv + (size_t)l * 1024 * 1024, 1024, Wl + OW_MKV, 1024, 0, scr, r, lane); continue; } r -= I_MKV;
        if (r < I_MO) { transpose_item(p.w_mo + (size_t)l * 512 * 1024, 1024, Wl + OW_MO, 512, 0, scr, r, lane); continue; } r -= I_MO;
        if (r < I_UP) { transpose_item(p.w_up + (size_t)l * 1024 * 5632, 5632, Wl + OW_UP, 1024, 0, scr, r, lane, true); continue; } r -= I_UP;
        transpose_item(p.w_down + (size_t)l * 2816 * 1024, 1024, Wl + OW_DOWN, 2816, 0, scr, r, lane);
    }
    for (int idx = gt; idx < 2 * 384 * 1024; idx += NGT) {
        const int l = idx / (384 * 1024), rem = idx - l * 384 * 1024, k = rem >> 10, n = rem & 1023, g = k / 96, cc = k - g * 96;
        const float* pw = p.pool_w + ((size_t)(l * 4 + g) * 96 + cc) * 96; const float* ps = p.pool_scale + l * 384 + g * 96; const float* wa = p.w_branch_a + ((size_t)l * 384 + g * 96) * 1024 + n;
        float a = 0.f;
        for (int d = 0; d < 96; ++d) a += pw[d] * ps[d] * wa[(size_t)d * 1024];
        ((bf16*)(p.ws + WS_W) + (size_t)l * LW + OW_CAT)[(size_t)n * 1024 + k] = (bf16)f2bf(a);
    }
    for (int idx = gt; idx < NB * S * 8; idx += NGT) {
        const int tok = idx >> 3, i = idx & 7;
        const float inv = __builtin_exp2f(-(float)i * (18.931568569324174f / 8.0f)), ang = (float)p.positions[tok] * inv;
        double rv = (double)ang * 0.15915494309189535; rv -= __builtin_floor(rv);
        const float sn = __builtin_amdgcn_sinf((float)rv), cn = __builtin_amdgcn_cosf((float)rv);
        float* cs = (float*)(p.ws + WS_CS) + (size_t)tok * 16; cs[i] = cn; cs[8 + i] = sn;
    }
    for (int rr = gw; rr < 2 * 2048; rr += NGW) {
        const int l = rr >> 11, row = rr & 2047;
        const f32x4* xr = (const f32x4*)(p.mem + (size_t)row * 1024) + lane; const f32x4* gr = (const f32x4*)(p.norm_memkv + l * 1024) + lane;
        f32x4 v[4]; float ss = 0.f;
#pragma unroll
        for (int j = 0; j < 4; ++j) { v[j] = xr[64 * j]; ss += v[j].x * v[j].x + v[j].y * v[j].y + v[j].z * v[j].z + v[j].w * v[j].w; }
        const float rs = 1.f / sqrtf(wave_sum(ss) * (1.f / 1024.f) + EPS);
        u32x2* o = (u32x2*)((bf16*)(p.ws + WS_HM) + ((size_t)l * 2048 + row) * 1024) + lane;
#pragma unroll
        for (int j = 0; j < 4; ++j) { const f32x4 gg = gr[64 * j]; u32x2 w; w.x = pk2(v[j].x * rs * gg.x, v[j].y * rs * gg.y); w.y = pk2(v[j].z * rs * gg.z, v[j].w * rs * gg.w); o[64 * j] = w; }
    }
}

__device__ __forceinline__ void prenorm_rows(const Params& p, int c, int pm, int pn) {
    const int tid = otid(), lane = tid & 63, wave = tid >> 6;
    bf16* H = (bf16*)(p.ws + WS_H);
    for (int k = 0; k < 8; ++k) {
        const int row = pm * 256 + pn * 64 + wave + 8 * k; const size_t grow = (size_t)c * TC + row;
        const f32x4* xr = (const f32x4*)(p.x + grow * 1024) + lane; const f32x4* gr = (const f32x4*)p.norm_mix_pre + lane;
        f32x4 v[4]; float ss = 0.f;
#pragma unroll
        for (int j = 0; j < 4; ++j) { v[j] = xr[64 * j]; ss += v[j].x * v[j].x + v[j].y * v[j].y + v[j].z * v[j].z + v[j].w * v[j].w; }
        const float rs = 1.f / sqrtf(wave_sum(ss) * (1.f / 1024.f) + EPS);
        u32x2* o = (u32x2*)(H + (size_t)row * 1024) + lane; u32x2* o16 = (u32x2*)((bf16*)(p.ws + WS_X16) + grow * 1024) + lane;
#pragma unroll
        for (int j = 0; j < 4; ++j) { const f32x4 gg = gr[64 * j]; u32x2 w; w.x = pk2(v[j].x * rs * gg.x, v[j].y * rs * gg.y); w.y = pk2(v[j].z * rs * gg.z, v[j].w * rs * gg.w); o[64 * j] = w;
            u32x2 xw; xw.x = pk2(v[j].x, v[j].y); xw.y = pk2(v[j].z, v[j].w); o16[64 * j] = xw; }
    }
}

template <int W> __device__ __forceinline__ void pool_item(const bf16* U, bf16* X, int row, int s, int c0) {
    float sum[8] = {0.f, 0.f, 0.f, 0.f, 0.f, 0.f, 0.f, 0.f};
    u32x4 v[W];
#pragma unroll
    for (int j = 0; j < W; ++j) v[j] = (s - j >= 0) ? *(const GAS u32x4*)(U + (size_t)(row - j) * 1536 + c0) : (u32x4){0u, 0u, 0u, 0u};
    u32x4 nx[3], ox[3];
#pragma unroll
    for (int k = 1; k < 4; ++k) { nx[k - 1] = *(const GAS u32x4*)(U + (size_t)(row + k) * 1536 + c0);
        ox[k - 1] = (s + k - W >= 0) ? *(const GAS u32x4*)(U + (size_t)(row + k - W) * 1536 + c0) : (u32x4){0u, 0u, 0u, 0u}; }
    float self[8]; unpack8(v[0], self);
#pragma unroll
    for (int j = 0; j < W; ++j) { float f[8]; unpack8(v[j], f);
#pragma unroll
        for (int e = 0; e < 8; ++e) sum[e] += f[e]; }
#pragma unroll
    for (int k = 0; k < 4; ++k) {
        if (k > 0) { float fn[8], fo[8]; unpack8(nx[k - 1], fn); unpack8(ox[k - 1], fo);
#pragma unroll
            for (int e = 0; e < 8; ++e) { sum[e] += fn[e] - fo[e]; self[e] = fn[e]; } }
        const int cnt = (s + k + 1) < W ? (s + k + 1) : W; const float ic = 1.f / (float)cnt; float o[8];
#pragma unroll
        for (int e = 0; e < 8; ++e) o[e] = sum[e] * ic - self[e];
        *(GAS u32x4*)(X + (size_t)(row + k) * 1024 + c0) = pack8(o); }
}
__device__ __forceinline__ void poolconv_phase(const Params& p, int l, int pm, int pn) {
    const int gt = otid(), NGT = NTHREADS;
    const bf16* U = (const bf16*)(p.ws + WS_UABC); bf16* X = (bf16*)(p.ws + WS_R2 + (size_t)pm * PSTRIDE + PO_XCAT) - (size_t)pm * 256 * 1024;
    const float* cw = p.conv_b_w + (size_t)l * 3 * 384;
    const int lane_ = gt & 63, wave_ = gt >> 6; (void)NGT;
    for (int kk = 0; kk < 3; ++kk) {
        const int wi = __builtin_amdgcn_readfirstlane(kk * 8 + wave_);
        if (wi < 12) {
            const int g = wi / 3, j = (wi - 3 * g) * 64 + lane_, rg = j / 12, ci = j - rg * 12, row = pm * 256 + pn * 64 + rg * 4, s = row & 4095, c0 = (g * 12 + ci) * 8;
            if (g == 0) pool_item<2>(U, X, row, s, c0); else if (g == 1) pool_item<4>(U, X, row, s, c0); else if (g == 2) pool_item<8>(U, X, row, s, c0); else pool_item<16>(U, X, row, s, c0);
        } else {
            const int j = (wi - 12) * 64 + lane_, rg = j / 48, it = 48 + (j - rg * 48), row = pm * 256 + pn * 64 + rg * 4, s = row & 4095;
            const int c0 = (it - 48) * 8;
            u32x4 bx[6], bc[6], bb[4];
#pragma unroll
            for (int j = 0; j < 6; ++j) { const bool ok = (j >= 2 || s > 0);
                bx[j] = ok ? *(const GAS u32x4*)(U + (size_t)(row - 2 + j) * 1536 + 384 + c0) : (u32x4){0u, 0u, 0u, 0u};
                bc[j] = ok ? *(const GAS u32x4*)(U + (size_t)(row - 2 + j) * 1536 + 1152 + c0) : (u32x4){0u, 0u, 0u, 0u}; }
#pragma unroll
            for (int j = 0; j < 4; ++j) bb[j] = *(const GAS u32x4*)(U + (size_t)(row + j) * 1536 + 768 + c0);
            float w[3][8];
#pragma unroll
            for (int j = 0; j < 3; ++j) { const f32x4 w0 = *(const GAS f32x4*)(cw + j * 384 + c0), w1 = *(const GAS f32x4*)(cw + j * 384 + c0 + 4);
#pragma unroll
                for (int e = 0; e < 4; ++e) { w[j][e] = w0[e]; w[j][4 + e] = w1[e]; } }
            float pr[6][8];
#pragma unroll
            for (int j = 0; j < 6; ++j) { float fx[8], fc[8]; unpack8(bx[j], fx); unpack8(bc[j], fc);
#pragma unroll
                for (int e = 0; e < 8; ++e) pr[j][e] = fc[e] * fx[e]; }
#pragma unroll
            for (int k = 0; k < 4; ++k) { float g[8], o[8]; unpack8(bb[k], g);
#pragma unroll
                for (int e = 0; e < 8; ++e) o[e] = g[e] * (w[0][e] * pr[k][e] + w[1][e] * pr[k + 1][e] + w[2][e] * pr[k + 2][e]);
                *(GAS u32x4*)(X + (size_t)(row + k) * 1024 + 384 + c0) = pack8(o); }
        }
    }
}

__device__ __forceinline__ void ffnfix_local(const Params& p, int l, int pm) {
    const int tid = otid();
    const float* RAWL = (const float*)(p.ws + WS_RAW); const float* RAWF = RAWL + 64 * 2 * DFF; bf16* Z = (bf16*)(p.ws + WS_R2 + (size_t)pm * PSTRIDE + PO_Z);
    const float* cw = p.conv_ffn_w + (size_t)l * 3 * DFF;
    for (int ch = tid * 2; ch < DFF; ch += NTHREADS * 2) {
        float z0[2], z1[2];
#pragma unroll
        for (int e = 0; e < 2; ++e) { const int c = ch + e;
            const float um2 = RAWL[((size_t)(pm - 1) * 2 + 0) * DFF + c], um1 = RAWL[((size_t)(pm - 1) * 2 + 1) * DFF + c];
            const float u0 = RAWF[((size_t)pm * 2 + 0) * (2 * DFF) + c], u1 = RAWF[((size_t)pm * 2 + 1) * (2 * DFF) + c];
            const float b0 = RAWF[((size_t)pm * 2 + 0) * (2 * DFF) + DFF + c], b1 = RAWF[((size_t)pm * 2 + 1) * (2 * DFF) + DFF + c];
            const float w0 = cw[c], w1 = cw[DFF + c], w2 = cw[2 * DFF + c];
            const float a0 = w0 * um2 + w1 * um1 + w2 * u0, a1 = w0 * um1 + w1 * u0 + w2 * u1;
            z0[e] = a0 / (1.f + __expf(-a0)) * b0; z1[e] = a1 / (1.f + __expf(-a1)) * b1; }
        *(unsigned*)(Z + ch) = pk2(z0[0], z0[1]); *(unsigned*)(Z + DFF + ch) = pk2(z1[0], z1[1]);
    }
    asm volatile("s_waitcnt vmcnt(0)" ::: "memory"); __syncthreads();
}

template <int NQH>
__device__ __forceinline__ void dil_tile(unsigned char* ws, LAS unsigned char* lds, int pm, int slot, int g, int r, int i0, int l15, int g4) {
    const int sh = 2 * g, Ld = S >> sh, bl = pm >> 4, t0 = (pm & 15) * 256, head = 4 * g + slot;
    const bf16* Qb = (const bf16*)(ws + WS_QP) + ((size_t)(bl * 12 + head) * S + (size_t)r * Ld + i0) * 64;
    const bf16* Kb = (const bf16*)(ws + WS_KP) + ((size_t)(bl * 12 + head) * S + (size_t)r * Ld) * 64;
    const bf16* Vb = (const bf16*)(ws + WS_VT) + ((size_t)(bl * 12 + head) * 128) * 2048;
    LAS float* Ob = (LAS float*)lds; LAS float* mb = Ob + 256 * 68; LAS float* lb = mb + 256;
    bf16* X = (bf16*)(ws + WS_R2 + (size_t)pm * PSTRIDE + PO_XCAT) - (size_t)pm * 256 * 1024;
    bf16x8 qf[NQH][2];
#pragma unroll
    for (int h = 0; h < NQH; ++h)
#pragma unroll
        for (int ks = 0; ks < 2; ++ks) qf[h][ks] = *(const GAS bf16x8*)(Qb + (16 * h + l15) * 64 + ks * 32 + g4 * 8);
    const int vp0 = r * Ld;
    bf16x8 vfa[2][5], vfb[2][5];
#define DIL_VLOAD(dst, dt0) _Pragma("unroll") for (int dt = 0; dt < 2; ++dt) _Pragma("unroll") for (int kb = 0; kb < 5; ++kb) { int pc = i0 - 128 + 32 * kb + 8 * g4; pc = pc < 0 ? 0 : (pc > Ld - 8 ? Ld - 8 : pc); \
        const int pos = vp0 + pc; dst[dt][kb] = *(const GAS bf16x8*)(Vb + (size_t)(pos >> 5) * 2048 + (16 * ((dt0) + dt) + l15) * 32 + (pos & 31)); }
    DIL_VLOAD(vfa, 0)
    f32x4 sc[NQH][5][2];
#pragma unroll
    for (int kb = 0; kb < 5; ++kb)
#pragma unroll
        for (int x = 0; x < 2; ++x) {
            const int kk = 32 * kb + 8 * (l15 >> 2) + 4 * x + (l15 & 3); int ik = i0 - 128 + kk; ik = ik < 0 ? 0 : (ik > Ld - 1 ? Ld - 1 : ik);
            const bf16x8 k0 = *(const GAS bf16x8*)(Kb + (size_t)ik * 64 + g4 * 8), k1 = *(const GAS bf16x8*)(Kb + (size_t)ik * 64 + 32 + g4 * 8);
#pragma unroll
            for (int h = 0; h < NQH; ++h) { f32x4 a = {0.f, 0.f, 0.f, 0.f};
                a = __builtin_amdgcn_mfma_f32_16x16x32_bf16(k0, qf[h][0], a, 0, 0, 0);
                a = __builtin_amdgcn_mfma_f32_16x16x32_bf16(k1, qf[h][1], a, 0, 0, 0);
                sc[h][kb][x] = a; }
        }
    DIL_VLOAD(vfb, 2)
#undef DIL_VLOAD
    float mxs[NQH], lss[NQH]; bf16x8 pf[NQH][5];
#pragma unroll
    for (int h = 0; h < NQH; ++h) {
        const int c = 16 * h + l15;
        float mx = -INFINITY;
#pragma unroll
        for (int kb = 0; kb < 5; ++kb)
#pragma unroll
            for (int x = 0; x < 2; ++x)
#pragma unroll
                for (int j = 0; j < 4; ++j) { const int kk = 32 * kb + 8 * g4 + 4 * x + j; const bool ok = (kk >= c) && (kk <= c + 128) && (i0 - 128 + kk >= 0);
                    const float v = ok ? sc[h][kb][x][j] : -INFINITY; sc[h][kb][x][j] = v; mx = fmaxf(mx, v); }
        mx = fmaxf(mx, __shfl_xor(mx, 16)); mx = fmaxf(mx, __shfl_xor(mx, 32));
        float ls = 0.f;
#pragma unroll
        for (int kb = 0; kb < 5; ++kb) { float f[8];
#pragma unroll
            for (int e = 0; e < 8; ++e) { f[e] = __builtin_amdgcn_exp2f(sc[h][kb][e >> 2][e & 3] - mx); ls += f[e]; }
            pf[h][kb] = __builtin_bit_cast(bf16x8, pack8(f)); }
        ls += __shfl_xor(ls, 16); ls += __shfl_xor(ls, 32);
        mxs[h] = mx; lss[h] = ls;
    }
#pragma unroll
    for (int h = 0; h < NQH; ++h) {
        const int c = 16 * h + l15; const float mx = mxs[h], ls = lss[h];
        f32x4 o[4];
#pragma unroll
        for (int dt = 0; dt < 4; ++dt) { o[dt] = (f32x4){0.f, 0.f, 0.f, 0.f};
#pragma unroll
            for (int kb = 0; kb < 5; ++kb) o[dt] = __builtin_amdgcn_mfma_f32_16x16x32_bf16(dt < 2 ? vfa[dt & 1][kb] : vfb[dt & 1][kb], pf[h][kb], o[dt], 0, 0, 0); }
        const int tl = (r + ((i0 + c) << sh)) - t0;
        LAS float* orow = Ob + tl * 68; const int rotc = 4 * (tl >> 4);
        if (g == 0) {
#pragma unroll
            for (int dt = 0; dt < 4; ++dt) *(LAS f32x4*)(orow + ((16 * dt + 4 * g4 + rotc) & 63)) = o[dt];
            if (g4 == 0) { mb[tl] = mx; lb[tl] = ls; }
        } else {
            const float mo = mb[tl], lo = lb[tl], mn = fmaxf(mo, mx), fa = exp2f(mo - mn), fb = exp2f(mx - mn), ln = fa * lo + fb * ls;
#pragma unroll
            for (int dt = 0; dt < 4; ++dt) { LAS f32x4* ptr = (LAS f32x4*)(orow + ((16 * dt + 4 * g4 + rotc) & 63)); o[dt] = (*ptr) * fa + o[dt] * fb; if (g == 1) *ptr = o[dt]; }
            if (g == 1) { if (g4 == 0) { mb[tl] = mn; lb[tl] = ln; } }
            else { const float il = 1.f / ln; bf16* xo = X + (size_t)(bl * S + t0 + tl) * 1024 + 768 + slot * 64 + 4 * g4;
#pragma unroll
                for (int dt = 0; dt < 4; ++dt) { u32x2 w; w.x = pk2(o[dt][0] * il, o[dt][1] * il); w.y = pk2(o[dt][2] * il, o[dt][3] * il); *(GAS u32x2*)(xo + 16 * dt) = w; } }
        }
    }
}
__device__ __forceinline__ void dilattn_phase(const Params& p, LAS unsigned char* lds, int pm, int pn) {
    const int tid = otid(), lane = tid & 63, wid = tid >> 6, l15 = lane & 15, g4 = lane >> 4;
    const int t0 = (pm & 15) * 256;
    __syncthreads();
    for (int g = 0; g < 3; ++g) {
        const int sh = 2 * g, tpr = 16 >> sh;
        if (g < 2) {
            const int qt = 2 * wid, r = qt / tpr, ib = qt - r * tpr, i0 = (t0 >> sh) + 16 * ib;
            dil_tile<2>(p.ws, lds, pm, pn, g, r, i0, l15, g4);
        } else {
#pragma unroll 1
            for (int qq = 0; qq < 2; ++qq) { const int qt = 2 * wid + qq, i0 = (t0 >> sh); dil_tile<1>(p.ws, lds, pm, pn, g, qt, i0, l15, g4); }
        }
        __syncthreads();
    }
}

__device__ __forceinline__ void memattn_phase(const Params& p, int l, int c, LAS unsigned char* lds, int pm, int pn) {
    const int tid = otid(), lane = tid & 63, wid = tid >> 6, l15 = lane & 15, g4 = lane >> 4;
    const bf16* QM = (const bf16*)(p.ws + WS_R2 + (size_t)pm * PSTRIDE + PO_QM) - (size_t)pm * 256 * 512; bf16* OM = (bf16*)(p.ws + WS_R2 + (size_t)pm * PSTRIDE + PO_OM) - (size_t)pm * 256 * 512;
    const bf16* MK = (const bf16*)(p.ws + WS_MEMK) + (size_t)l * 2048 * 512; const bf16* MV = (const bf16*)(p.ws + WS_MEMVT) + (size_t)l * 512 * 2048;
    constexpr int KP = 272, VP = 528, VOFF = 256 * KP;
    {
        const int bl = pm >> 4, head = pn, qb = pm & 15, b = c * BC + bl;
        __syncthreads();
        { u32x4 kv[8], vv[8];
#pragma unroll
        for (int i = 0; i < 8; ++i) { const int ch = tid + 512 * i, row = ch >> 4, c16 = ch & 15; kv[i] = *(const GAS u32x4*)(MK + (size_t)(b * 256 + row) * 512 + head * 128 + c16 * 8); }
#pragma unroll
        for (int i = 0; i < 8; ++i) { const int ch = tid + 512 * i, d = ch >> 5, k8 = ch & 31; vv[i] = *(const GAS u32x4*)(MV + (size_t)(head * 128 + d) * 2048 + b * 256 + k8 * 8); }
#pragma unroll
        for (int i = 0; i < 8; ++i) { const int ch = tid + 512 * i, row = ch >> 4, c16 = ch & 15; *(LAS u32x4*)(lds + row * KP + c16 * 16) = kv[i]; }
#pragma unroll
        for (int i = 0; i < 8; ++i) { const int ch = tid + 512 * i, d = ch >> 5, k8 = ch & 31, blk = k8 >> 2, kin = (k8 & 3) * 8; const u32x4 v = vv[i];
            const int p0 = (kin < 16) ? 8 * (kin >> 2) : 8 * ((kin - 16) >> 2) + 4, p1 = (kin + 4 < 16) ? 8 * ((kin + 4) >> 2) : 8 * ((kin + 4 - 16) >> 2) + 4;
            *(LAS u32x2*)(lds + VOFF + d * VP + (blk * 32 + p0) * 2) = (u32x2){v.x, v.y};
            *(LAS u32x2*)(lds + VOFF + d * VP + (blk * 32 + p1) * 2) = (u32x2){v.z, v.w}; } }
        asm volatile("s_waitcnt lgkmcnt(0)" ::: "memory"); __syncthreads();
        for (int qq = 0; qq < 2; ++qq) {
            const int row0 = bl * S + 256 * qb + 32 * wid + 16 * qq;
            bf16x8 qf[4];
#pragma unroll
            for (int ks = 0; ks < 4; ++ks) qf[ks] = *(const GAS bf16x8*)(QM + (size_t)(row0 + l15) * 512 + head * 128 + ks * 32 + g4 * 8);
            f32x4 o[8];
#pragma unroll
            for (int dt = 0; dt < 8; ++dt) o[dt] = (f32x4){0.f, 0.f, 0.f, 0.f};
            float mrun = -INFINITY, lrun = 0.f;
#pragma unroll 1
            for (int half = 0; half < 2; ++half) {
                f32x4 sc[4][2];
#pragma unroll
                for (int kb = 0; kb < 4; ++kb)
#pragma unroll
                    for (int x = 0; x < 2; ++x) { const int key = 128 * half + 32 * kb + 16 * x + l15;
                        const LAS unsigned char* kr = lds + key * KP + g4 * 16; f32x4 a = {0.f, 0.f, 0.f, 0.f};
#pragma unroll
                        for (int ks = 0; ks < 4; ++ks) a = __builtin_amdgcn_mfma_f32_16x16x32_bf16(*(const LAS bf16x8*)(kr + ks * 64), qf[ks], a, 0, 0, 0);
                        sc[kb][x] = a; }
                float mx = mrun;
#pragma unroll
                for (int kb = 0; kb < 4; ++kb)
#pragma unroll
                    for (int x = 0; x < 2; ++x)
#pragma unroll
                        for (int j = 0; j < 4; ++j) mx = fmaxf(mx, sc[kb][x][j]);
                mx = fmaxf(mx, __shfl_xor(mx, 16)); mx = fmaxf(mx, __shfl_xor(mx, 32));
                const float alpha = exp2f(mrun - mx); mrun = mx;
                float ls = 0.f; bf16x8 pf[4];
#pragma unroll
                for (int kb = 0; kb < 4; ++kb) { float f[8];
#pragma unroll
                    for (int e = 0; e < 8; ++e) { f[e] = __builtin_amdgcn_exp2f(sc[kb][e >> 2][e & 3] - mx); ls += f[e]; }
                    pf[kb] = __builtin_bit_cast(bf16x8, pack8(f)); }
                ls += __shfl_xor(ls, 16); ls += __shfl_xor(ls, 32);
                lrun = lrun * alpha + ls;
#pragma unroll
                for (int dt = 0; dt < 8; ++dt) { o[dt] = o[dt] * alpha;
#pragma unroll
                    for (int kb = 0; kb < 4; ++kb) o[dt] = __builtin_amdgcn_mfma_f32_16x16x32_bf16(*(const LAS bf16x8*)(lds + VOFF + (16 * dt + l15) * VP + (128 * half + 32 * kb + 8 * g4) * 2), pf[kb], o[dt], 0, 0, 0); }
            }
            const float il = 1.f / lrun;
            bf16* orow = OM + (size_t)(row0 + l15) * 512 + head * 128 + 4 * g4;
#pragma unroll
            for (int dt = 0; dt < 8; ++dt) { u32x2 w; w.x = pk2(o[dt][0] * il, o[dt][1] * il); w.y = pk2(o[dt][2] * il, o[dt][3] * il); *(GAS u32x2*)(orow + 16 * dt) = w; }
        }
    }
}

#define XB_TMO      128
#define XB_XCNT(j)  (256  + 64 * (j))
#define XB_XSUB(j)  (1280 + 64 * (j))
#define XB_XGEN(j)  (2304 + 64 * (j))
#define XB_TOP      3328
#define XB_TOPGEN   3392
#define XCD_BAR_WORDS 3456
#define XB_SPIN_CAP (1u << 22)
__device__ __forceinline__ unsigned xb_ld(unsigned* p)              { return __hip_atomic_load(p, __ATOMIC_RELAXED, __HIP_MEMORY_SCOPE_AGENT); }
__device__ __forceinline__ unsigned xb_add(unsigned* p, unsigned v) { return __hip_atomic_fetch_add(p, v, __ATOMIC_RELAXED, __HIP_MEMORY_SCOPE_AGENT); }
__device__ __forceinline__ unsigned xb_xcc_id() { return (unsigned)__builtin_amdgcn_s_getreg((3 << 11) | 20) & 0xFu; }
#define XB_SPIN(cond, bar) do { unsigned _sp = 0; while (cond) { __builtin_amdgcn_s_sleep(1); \
    if ((++_sp & 255u) == 0u) { if (xb_ld(&(bar)[XB_TMO])) break; if (_sp > XB_SPIN_CAP) { atomicAdd(&(bar)[XB_TMO], 1u); break; } } } } while (0)
struct XcdBarrier { unsigned* bar; unsigned x; volatile LAS unsigned* st; };
__device__ __forceinline__ XcdBarrier xcd_barrier_post(unsigned* bar, volatile LAS unsigned* st) {
    XcdBarrier b; b.bar = bar; b.x = xb_xcc_id(); b.st = st;
    if (threadIdx.x == 0) (void)xb_add(&bar[XB_XCNT(b.x)], 1u);
    return b;
}
__device__ __forceinline__ void xcd_barrier_complete(unsigned* bar, unsigned x, unsigned& nloc, unsigned& nx) {
    const unsigned G = gridDim.x * gridDim.y * gridDim.z;
    unsigned sum, cnt, mine, sp = 0u;
    for (;;) {
        sum = 0u; cnt = 0u; mine = 0u;
#pragma unroll
        for (unsigned j = 0; j < 16; ++j) { const unsigned c = xb_ld(&bar[XB_XCNT(j)]); sum += c; cnt += (c > 0u) ? 1u : 0u; mine = (j == x) ? c : mine; }
        if (sum == G) break;
        __builtin_amdgcn_s_sleep(1);
        if ((++sp & 255u) == 0u) { if (xb_ld(&bar[XB_TMO])) break; if (sp > XB_SPIN_CAP) { atomicAdd(&bar[XB_TMO], 1u); break; } }
    }
    nloc = mine > 0u ? mine : 1u; nx = cnt > 0u ? cnt : 1u;
}
__device__ __forceinline__ void xcd_barrier(const XcdBarrier& b) {
    asm volatile("s_waitcnt vmcnt(0)" ::: "memory");
    __syncthreads();
    if (threadIdx.x == 0) {
        unsigned* bar = b.bar;
        __builtin_amdgcn_s_waitcnt(0);
        unsigned nloc = b.st[0], nx = b.st[1];
        if (nloc == 0u) { xcd_barrier_complete(bar, b.x, nloc, nx); b.st[0] = nloc; b.st[1] = nx; }
        const unsigned old = xb_add(&bar[XB_XSUB(b.x)], 1u);
        const unsigned gen = old / nloc;
        if (old + 1u == (gen + 1u) * nloc) {
            __builtin_amdgcn_fence(__ATOMIC_RELEASE, "agent");
            asm volatile("s_waitcnt vmcnt(0)" ::: "memory");
            const unsigned og = xb_add(&bar[XB_TOP], 1u);
            const unsigned tg = og / nx;
            if (og + 1u == (tg + 1u) * nx) xb_add(&bar[XB_TOPGEN], 1u);
            else XB_SPIN(xb_ld(&bar[XB_TOPGEN]) == tg, bar);
            __builtin_amdgcn_fence(__ATOMIC_ACQUIRE, "agent");
            xb_add(&bar[XB_XGEN(b.x)], 1u);
            asm volatile("s_waitcnt vmcnt(0)" ::: "memory");
        } else {
            XB_SPIN(xb_ld(&bar[XB_XGEN(b.x)]) == gen, bar);
            __builtin_amdgcn_fence(__ATOMIC_ACQUIRE, "agent");
            asm volatile("s_waitcnt vmcnt(0)" ::: "memory");
        }
    }
    __syncthreads();
}

__device__ __forceinline__ void panel_barrier(unsigned* cnt, unsigned target, bool same_xcd) {
    asm volatile("s_waitcnt vmcnt(0)" ::: "memory");
    __syncthreads();
    if (threadIdx.x == 0) {
        if (!same_xcd) { __builtin_amdgcn_fence(__ATOMIC_RELEASE, "agent"); asm volatile("s_waitcnt vmcnt(0)" ::: "memory"); }
        __hip_atomic_fetch_add(cnt, 1u, __ATOMIC_RELAXED, __HIP_MEMORY_SCOPE_AGENT);
        unsigned sp = 0;
        while (__hip_atomic_load(cnt, __ATOMIC_RELAXED, __HIP_MEMORY_SCOPE_AGENT) < target) { __builtin_amdgcn_s_sleep(1); if (++sp > (1u << 24)) break; }
        __builtin_amdgcn_fence(__ATOMIC_ACQUIRE, "agent");
        asm volatile("s_waitcnt vmcnt(0)" ::: "memory");
    }
    __syncthreads();
}
__device__ __forceinline__ void panel_wait(unsigned* cnt, unsigned target) {
    if (threadIdx.x == 0) {
        unsigned sp = 0;
        while (__hip_atomic_load(cnt, __ATOMIC_RELAXED, __HIP_MEMORY_SCOPE_AGENT) < target) { __builtin_amdgcn_s_sleep(1); if (++sp > (1u << 24)) break; }
        __builtin_amdgcn_fence(__ATOMIC_ACQUIRE, "agent");
        asm volatile("s_waitcnt vmcnt(0)" ::: "memory");
    }
    __syncthreads();
}

__global__ void __launch_bounds__(NTHREADS, 2) mega(Params p) {
    extern __shared__ __attribute__((aligned(16))) unsigned char lds_raw[];
    LAS unsigned char* lds = (LAS unsigned char*)lds_raw;
    cg::grid_group grid = cg::this_grid();
    volatile LAS unsigned* st = (volatile LAS unsigned*)(lds + LDS_CTL + 256);
    if (threadIdx.x < 2) st[threadIdx.x] = 0u;
    __syncthreads();
    const XcdBarrier xb = xcd_barrier_post((unsigned*)p.ws, st);
    unsigned pgen = 0; bool same_xcd = false;
    { int pm0, pn0; pg8::pmpn(pg8::xcd_remap((int)blockIdx.x, 256), 64, 4, pm0, pn0);
      if (threadIdx.x == 0) __hip_atomic_store((unsigned*)(p.ws + 49152) + 4 * pm0 + pn0, xb.x + 1u, __ATOMIC_RELAXED, __HIP_MEMORY_SCOPE_AGENT); }
    constexpr int NSTEP = 1 + NCH * 2 * 9;
    for (int step = 0; step < NSTEP; ++step) {
        Params q = p; { unsigned char* wsq = p.ws; asm volatile("" : "+s"(wsq)); q.ws = wsq; }
        int bid = blockIdx.x; asm volatile("" : "+s"(bid));
        int pm, pn; pg8::pmpn(pg8::xcd_remap(bid, 256), 64, 4, pm, pn);
        int gt = -1; Ctx C{q.ws, 0, 0}; bool gb = true;
        const void* nx = nullptr; const float* ngpost = nullptr; const float* ngpre = nullptr; int ninst = 0, ndst32 = 0;
        if (step == 0) { init_phase(q, lds); prenorm_rows(q, 0, pm, pn); }
        else {
            const int s2 = step - 1, c = s2 / 18, r = s2 - c * 18, l = r / 9, k = r - l * 9;
            C.l = l; C.c = c; gb = (k == 0 || k == 8);
            switch (k) {
            case 0: gt = G_WIN; break;
            case 1: poolconv_phase(q, l, pm, pn); dilattn_phase(q, lds, pm, pn); break;
            case 2: gt = G_CHAIN; break;
            case 3: gt = G_OUT; nx = q.ws + WS_X16; ngpost = q.norm_mix_post + l * 1024; ngpre = q.norm_mem_pre + l * 1024; ninst = (c * 2 + l) * 3 + 0; break;
            case 4: gt = G_MQ; break;
            case 5: memattn_phase(q, l, c, lds, pm, pn); break;
            case 6: gt = G_MO; nx = q.ws + WS_X16; ngpost = q.norm_mem_post + l * 1024; ngpre = q.norm_ffn_pre + l * 1024; ninst = (c * 2 + l) * 3 + 1; break;
            case 7: gt = G_UP; break;
            default: gt = G_DOWN; nx = q.ws + WS_X16; ndst32 = (l == 1); ngpost = q.norm_ffn_post + l * 1024; ngpre = l == 0 ? q.norm_mix_pre + 1024 : nullptr; ninst = (c * 2 + l) * 3 + 2;
                if (pm & 15) { panel_wait((unsigned*)(q.ws + WS_PCNT) + 64 * (pm - 1), 4u * pgen); ffnfix_local(q, l, pm); }
                break;
            }
        }
        if (gt >= 0) { Gen G{C, gt, pm, pn};
            if (gt == G_WIN) { Epi<1> E{C}; pg8::gemm_phase(lds, G, E); }
            else if (gt == G_CHAIN) { Epi<2> E{C}; pg8::gemm_phase(lds, G, E); }
            else if (gt == G_UP) { Epi<4> E{C, nullptr, nullptr, q.conv_ffn_w + (size_t)C.l * 3 * DFF, nullptr, nullptr, nullptr, lds + LDS_CTL + 1024, 0}; pg8::gemm_phase(lds, G, E); }
            else if (nx) { Epi<3> E{C, nx, ndst32 ? (void*)q.out : (void*)(q.ws + WS_X16), ngpost, ngpre, q.ws + WS_SSQ + 65536 + (size_t)ninst * SSQ_INST, (unsigned*)(q.ws + WS_SSQ) + ninst * 128, lds + LDS_CTL + 1024, ndst32}; pg8::gemm_phase(lds, G, E); }
            else { Epi<0> E{C}; pg8::gemm_phase(lds, G, E); } }
        if (step == 1 + 17) prenorm_rows(q, 1, pm, pn);
        if (step + 1 < NSTEP) {
            if (step == 0) { if (p.ph_lo == 0x5eed) grid.sync(); else xcd_barrier(xb);
                unsigned* xid = (unsigned*)(q.ws + 49152) + 4 * pm;
                const unsigned x0 = __hip_atomic_load(xid + 0, __ATOMIC_RELAXED, __HIP_MEMORY_SCOPE_AGENT), x1 = __hip_atomic_load(xid + 1, __ATOMIC_RELAXED, __HIP_MEMORY_SCOPE_AGENT),
                               x2 = __hip_atomic_load(xid + 2, __ATOMIC_RELAXED, __HIP_MEMORY_SCOPE_AGENT), x3 = __hip_atomic_load(xid + 3, __ATOMIC_RELAXED, __HIP_MEMORY_SCOPE_AGENT);
                same_xcd = __builtin_amdgcn_readfirstlane((int)((x0 == x1) && (x1 == x2) && (x2 == x3) && (x0 == xb.x + 1u))) != 0; }
            else if (gb) xcd_barrier(xb);
            else { ++pgen; const int kk = (step - 1) % 9; panel_barrier((unsigned*)(q.ws + WS_PCNT) + 64 * pm, 4u * pgen, same_xcd && kk != 7); }
        }
    }
}

extern "C" void kernel_launch(void* const* d_in, const int* in_sizes, int n_in, void* d_out, int out_size, void* d_ws, size_t ws_size, hipStream_t stream) {
    static int grid = 0;
    if (grid == 0) {
        if (n_in != 24 || ws_size < WS_END) { fprintf(stderr, "kernel_launch: unexpected n_in %d / ws_size %zu\n", n_in, ws_size); grid = -1; return; }
        int dev = 0, cus = 0, per_cu = 0;
        hipGetDevice(&dev); hipDeviceGetAttribute(&cus, hipDeviceAttributeMultiprocessorCount, dev);
        hipFuncSetAttribute((const void*)mega, hipFuncAttributeMaxDynamicSharedMemorySize, LDS_BYTES);
        hipOccupancyMaxActiveBlocksPerMultiprocessor(&per_cu, (const void*)mega, NTHREADS, LDS_BYTES);
        if (per_cu < 1) per_cu = 1;
        grid = cus * per_cu;
        if (grid != 256) { fprintf(stderr, "kernel_launch: this kernel needs exactly 256 co-resident workgroups (got %d)\n", grid); grid = -1; return; }
        (void)hipGetLastError();
    }
    if (grid < 0) return;
    (void)hipMemsetAsync(d_ws, 0, 65536, stream);
    (void)hipMemsetAsync((char*)d_ws + WS_SSQ, 0, 8192, stream);
    Params p{};
    p.x = (const float*)d_in[0]; p.mem = (const float*)d_in[1]; p.positions = (const int*)d_in[2];
    p.norm_mix_pre = (const float*)d_in[3]; p.norm_mix_post = (const float*)d_in[4]; p.w_in = (const float*)d_in[5]; p.pool_w = (const float*)d_in[6]; p.pool_scale = (const float*)d_in[7];
    p.conv_b_w = (const float*)d_in[8]; p.w_branch_a = (const float*)d_in[9]; p.w_branch_b = (const float*)d_in[10]; p.w_branch_c = (const float*)d_in[11]; p.w_out = (const float*)d_in[12];
    p.norm_mem_pre = (const float*)d_in[13]; p.norm_mem_post = (const float*)d_in[14]; p.norm_memkv = (const float*)d_in[15]; p.w_mq = (const float*)d_in[16]; p.w_mkv = (const float*)d_in[17]; p.w_mo = (const float*)d_in[18];
    p.norm_ffn_pre = (const float*)d_in[19]; p.norm_ffn_post = (const float*)d_in[20]; p.w_up = (const float*)d_in[21]; p.conv_ffn_w = (const float*)d_in[22]; p.w_down = (const float*)d_in[23];
    p.out = (float*)d_out; p.ws = (unsigned char*)d_ws;
#if 1
    p.ph_lo = 0; p.ph_hi = 0;
    void* args[] = {&p};
    hipError_t e = hipLaunchCooperativeKernel((const void*)mega, dim3(grid), dim3(NTHREADS), args, LDS_BYTES, stream);
    if (e != hipSuccess) fprintf(stderr, "cooperative launch failed: %s (grid %d)\n", hipGetErrorString(e), grid);
#else
    for (int s = 0; s < N_STEPS; ++s) { p.ph_lo = s; p.ph_hi = s + 1; hipLaunchKernelGGL(mega, dim3(grid), dim3(NTHREADS), LDS_BYTES, stream, p); }
#endif
}
```
